# Optimizing an MI355X kernel written in HIP

```python
import math
import jax, jax.numpy as jnp
from jax import lax
import numpy as np

D_MODEL = 1024
BATCH = 4
SEQ = 8192
DEPTH = 1

CHUNK = 64
Q_BLOCK = 128
CONV_WIDTH = 3
D_CONV = D_MODEL // 2
N_HEADS_DIFF = 4
DH_DIFF = 64
DV_DIFF = 2 * DH_DIFF
D_ATTN = N_HEADS_DIFF * DV_DIFF
D_FF = ((8 * D_MODEL // 3 + 255) // 256) * 256
EPS = 1e-6
NEG_INF = -1e30
COLS_CONV = 3 * D_CONV
COLS_ATTN = 3 * D_ATTN
COLS_GATES = 2 * D_MODEL
D_IN_TOTAL = COLS_CONV + COLS_ATTN + COLS_GATES

kernel_name = "hybrid_shortconv_diffattn_gated_block"


def rms_norm(x, g):
    xf = x.astype(jnp.float32)
    y = xf * lax.rsqrt(jnp.mean(xf * xf, axis=-1, keepdims=True) + EPS)
    return y.astype(x.dtype) * g


def alibi_slopes(n_heads):
    return jnp.asarray([2.0 ** (-8.0 * (i + 1) / n_heads) for i in range(n_heads)], dtype=jnp.float32)


def lambda_init_for(layer_idx):
    return 0.8 - 0.6 * math.exp(-0.3 * layer_idx)


def causal_depthwise_conv(u, w):
    S = u.shape[1]
    k = w.shape[0]
    up = jnp.pad(u, ((0, 0), (k - 1, 0), (0, 0)))
    out = up[:, 0:S] * w[0]
    for i in range(1, k):
        out = out + up[:, i:i + S] * w[i]
    return out


def short_conv_branch(u, gb, gc, conv_w, w_out_a):
    z = causal_depthwise_conv(gc * u, conv_w)
    return (gb * z) @ w_out_a


def diff_attention_branch(q, k, v, lam, subln_g, lambda_init, w_out_b):
    Bsz, S = q.shape[0], q.shape[1]
    nblk = S // Q_BLOCK
    scale = 1.0 / math.sqrt(DH_DIFF)
    slopes = alibi_slopes(N_HEADS_DIFF)
    kpos = jnp.arange(S, dtype=jnp.int32)
    kchunk = kpos // CHUNK
    q_blocks = jnp.moveaxis(q.reshape(Bsz, nblk, Q_BLOCK, N_HEADS_DIFF, 2, DH_DIFF), 1, 0)
    qpos_blocks = kpos.reshape(nblk, Q_BLOCK)

    def one_block(args):
        qb, qpos = args
        s = jnp.einsum('bqhcd,bkhcd->bhcqk', qb.astype(jnp.float32), k.astype(jnp.float32)) * scale
        dist = jnp.abs(qpos[:, None] - kpos[None, :]).astype(jnp.float32)
        bias = -slopes[:, None, None] * dist[None]
        allowed = kchunk[None, :] <= (qpos // CHUNK)[:, None]
        s = jnp.where(allowed[None, None, None], s + bias[None, :, None], NEG_INF)
        p = jax.nn.softmax(s, axis=-1)
        a = (p[:, :, 0] - lam * p[:, :, 1]).astype(v.dtype)
        return jnp.einsum('bhqk,bkhe->bqhe', a, v)

    o = lax.map(one_block, (q_blocks, qpos_blocks))
    o = jnp.moveaxis(o, 0, 1).reshape(Bsz, S, N_HEADS_DIFF, DV_DIFF)
    o = rms_norm(o, subln_g) * (1.0 - lambda_init)
    return o.reshape(Bsz, S, D_ATTN) @ w_out_b


def swiglu(h, w_gate, w_up, w_down):
    return (jax.nn.silu(h @ w_gate) * (h @ w_up)) @ w_down


def setup_inputs(seed: int = 0) -> dict:
    key = jax.random.key(seed)
    ks = jax.random.split(key, 24)
    n = jax.random.normal
    L, D = DEPTH, D_MODEL
    return {
        "x": n(ks[0], (BATCH, SEQ, D), jnp.float32),
        "c": n(ks[1], (BATCH, D), jnp.float32),
        "w_ada": n(ks[2], (L, D, 6 * D), jnp.float32) * (0.2 * D ** -0.5),
        "b_ada": n(ks[3], (L, 6 * D), jnp.float32) * 0.02,
        "g_mix": 1.0 + 0.05 * n(ks[4], (L, D), jnp.float32),
        "w_in": n(ks[5], (L, D, D_IN_TOTAL), jnp.float32) * D ** -0.5,
        "conv_w": n(ks[6], (L, CONV_WIDTH, D_CONV), jnp.float32) * CONV_WIDTH ** -0.5,
        "w_out_a": n(ks[7], (L, D_CONV, D), jnp.float32) * D_CONV ** -0.5,
        "lambda_q1": n(ks[8], (L, DH_DIFF), jnp.float32) * 0.1,
        "lambda_k1": n(ks[9], (L, DH_DIFF), jnp.float32) * 0.1,
        "lambda_q2": n(ks[10], (L, DH_DIFF), jnp.float32) * 0.1,
        "lambda_k2": n(ks[11], (L, DH_DIFF), jnp.float32) * 0.1,
        "subln_g": 1.0 + 0.05 * n(ks[12], (L, DV_DIFF), jnp.float32),
        "w_out_b": n(ks[13], (L, D_ATTN, D), jnp.float32) * D_ATTN ** -0.5,
        "w_out": n(ks[14], (L, D, D), jnp.float32) * D ** -0.5,
        "g_ffn": 1.0 + 0.05 * n(ks[15], (L, D), jnp.float32),
        "w_gate": n(ks[16], (L, D, D_FF), jnp.float32) * D ** -0.5,
        "w_up": n(ks[17], (L, D, D_FF), jnp.float32) * D ** -0.5,
        "w_down": n(ks[18], (L, D_FF, D), jnp.float32) * D_FF ** -0.5,
        "g_final": 1.0 + 0.05 * n(ks[19], (D,), jnp.float32),
    }


def reference(x, c, w_ada, b_ada, g_mix, w_in, conv_w, w_out_a, lambda_q1, lambda_k1,
              lambda_q2, lambda_k2, subln_g, w_out_b, w_out, g_ffn, w_gate, w_up, w_down,
              g_final):
    Bsz, S, D = x.shape
    for l in range(DEPTH):
        lambda_init = lambda_init_for(l + 1)
        mod = jax.nn.silu(c) @ w_ada[l] + b_ada[l]
        sh_m, sc_m, gt_m, sh_f, sc_f, gt_f = [m[:, None, :] for m in jnp.split(mod, 6, axis=-1)]

        h = rms_norm(x, g_mix[l]) * (1.0 + sc_m) + sh_m
        proj = h @ w_in[l]
        p_conv = proj[..., :COLS_CONV]
        p_attn = proj[..., COLS_CONV:COLS_CONV + COLS_ATTN]
        p_gate = proj[..., COLS_CONV + COLS_ATTN:]

        u, gb, gc = jnp.split(p_conv, 3, axis=-1)
        y_a = short_conv_branch(u, gb, gc, conv_w[l], w_out_a[l])

        q, k, v = jnp.split(p_attn, 3, axis=-1)
        q = q.reshape(Bsz, S, N_HEADS_DIFF, 2, DH_DIFF)
        k = k.reshape(Bsz, S, N_HEADS_DIFF, 2, DH_DIFF)
        v = v.reshape(Bsz, S, N_HEADS_DIFF, DV_DIFF)
        lam = (jnp.exp(jnp.sum(lambda_q1[l].astype(jnp.float32) * lambda_k1[l].astype(jnp.float32)))
               - jnp.exp(jnp.sum(lambda_q2[l].astype(jnp.float32) * lambda_k2[l].astype(jnp.float32)))
               + lambda_init)
        y_b = diff_attention_branch(q, k, v, lam, subln_g[l], lambda_init, w_out_b[l])

        g_a, g_b = jnp.split(p_gate, 2, axis=-1)
        merged = jax.nn.sigmoid(g_a) * y_a + jax.nn.sigmoid(g_b) * y_b
        x = x + gt_m * (merged @ w_out[l])

        h2 = rms_norm(x, g_ffn[l]) * (1.0 + sc_f) + sh_f
        x = x + gt_f * swiglu(h2, w_gate[l], w_up[l], w_down[l])
    return rms_norm(x, g_final)
```

```cpp
#include <hip/hip_runtime.h>
#include <hip/hip_cooperative_groups.h>
#include <cstdio>
#include <cstdint>
namespace cg = cooperative_groups;

#define LAS __attribute__((address_space(3)))
typedef unsigned short bf16_t;
typedef short bf16x8 __attribute__((ext_vector_type(8)));
typedef float f32x4 __attribute__((ext_vector_type(4)));
typedef float f32x2 __attribute__((ext_vector_type(2)));
typedef float f32x16 __attribute__((ext_vector_type(16)));
typedef unsigned u32x4 __attribute__((ext_vector_type(4)));
typedef unsigned u32x2 __attribute__((ext_vector_type(2)));
typedef __bf16 bf16x2_t __attribute__((ext_vector_type(2)));
typedef _Float16 h16x4 __attribute__((ext_vector_type(4)));

constexpr int BATCH = 4, SEQ = 8192, DM = 1024, M = BATCH * SEQ;
constexpr int DIN = 5120, NP = 4608  , DC = 512, DA = 512, FF = 2816, NGU = 2 * FF;
constexpr int NHEAD = 4;
constexpr float EPS = 1e-6f;
constexpr float LOG2E = 1.4426950408889634f;
constexpr float QSCALE = 0.125f * LOG2E;
constexpr int PC_U = 0, PC_GB = 512, PC_GC = 1024, PC_Q = 1536, PC_K = 2048, PC_GA = 2560, PC_GBT = 3584;
constexpr int PP = 2560;

constexpr size_t MiB = 1u << 20;
constexpr size_t WS_MOD = 1 * MiB;
constexpr size_t WS_WIN = 2 * MiB;
constexpr size_t WS_WOA = 12 * MiB;
constexpr size_t WS_WOB = 13 * MiB;
constexpr size_t WS_WOUT = 14 * MiB;
constexpr size_t WS_WGU = 16 * MiB;
constexpr size_t WS_WD = 27 * MiB;
constexpr size_t WS_RSS = 34 * MiB;
constexpr size_t WS_XN = 40 * MiB;
constexpr size_t WS_PROJ = 104 * MiB;
constexpr int VTP = M + 64;
constexpr size_t WS_VT = 392 * MiB;
constexpr size_t WS_CONVA = 425 * MiB;
constexpr size_t WS_ATTNO = 457 * MiB;
constexpr size_t WS_END = 489 * MiB;

constexpr int CW_QUEUE = 8192, CW_NRM = 8320, CW_CNT1 = 16384, CW_CNT2 = 20480;
constexpr int LDS_BYTES = 147456;
constexpr int NTHREADS = 512;

#define LOG2E_ 1.4426950408889634f
__device__ __forceinline__ unsigned cvtpk(float lo, float hi) { f32x2 v = {lo, hi}; bf16x2_t b = __builtin_convertvector(v, bf16x2_t); return __builtin_bit_cast(unsigned, b); }
__device__ __forceinline__ float bf_lo(unsigned w) { return __uint_as_float(w << 16); }
__device__ __forceinline__ float bf_hi(unsigned w) { return __uint_as_float(w & 0xffff0000u); }
__device__ __forceinline__ float sigmoid_f(float v) { return __builtin_amdgcn_rcpf(1.f + __builtin_amdgcn_exp2f(-LOG2E_ * v)); }
__device__ __forceinline__ float silu_f(float v) { return v * __builtin_amdgcn_rcpf(1.f + __builtin_amdgcn_exp2f(-LOG2E_ * v)); }
__device__ __forceinline__ float wave_sum(float v) {
#pragma unroll
    for (int o = 1; o < 64; o <<= 1) v += __shfl_xor(v, o);
    return v;
}

namespace pg8 {
constexpr int BM = 256, BK = 64, HALF = 128, HTB = HALF * BK * 2, STAGE_BYTES = 8 * HTB, NXCD = 8, WGM = 8;
__host__ __device__ __forceinline__ int lds_byte(int r, int c) { const int st = (r >> 4) * 2 + (c >> 5), rr = r & 15, cc = c & 31, ob = rr * 64 + cc * 2; return st * 1024 + (ob ^ (((ob >> 9) & 1) << 5)); }
__host__ __device__ __forceinline__ void stage_rc(int b, int& R, int& C) { const int st = b / 1024, sb = b % 1024, swz = sb ^ (((sb >> 9) & 1) << 5); R = (st >> 1) * 16 + swz / 64; C = (st & 1) * 32 + (swz % 64) / 2; }
__host__ __device__ __forceinline__ int perm32(int rho) { const int n = rho >> 4, i = rho & 15; return 8 * (i >> 2) + 4 * n + (i & 3); }

struct Unit { int pm, pn, kind; };
struct Gemm { const bf16_t* A; const bf16_t* Bt; int M, N, K; const bf16_t* A1 = nullptr; const bf16_t* Bt1 = nullptr; };

struct StaticOrder {
    int nM, nN, nwg, G, c;
    __host__ __device__ void init(int M_, int N_, int G_, int c_) { nM = M_ / BM; nN = N_ / BM; nwg = nM * nN; G = G_; c = c_; }
    __host__ __device__ bool next(int i, Unit& u) const {
        const long L = (long)i * G + c; if (L >= nwg) return false;
        int wgid = (int)L; { const int q = nwg / NXCD, r = nwg % NXCD, xcd = wgid % NXCD, off = wgid / NXCD; wgid = (xcd < r ? xcd * (q + 1) : r * (q + 1) + (xcd - r) * q) + off; }
        const int nig = WGM * nN, gid = wgid / nig, fm = gid * WGM, gsz = (nM - fm) < WGM ? (nM - fm) : WGM;
        u.pm = fm + ((wgid % nig) % gsz); u.pn = (wgid % nig) / gsz; u.kind = 0; return true;
    }
    __device__ __forceinline__ void a_ready(const Unit&) const {}
    __device__ __forceinline__ void done(const Unit&) const {}
};

struct ChainOrder {
    StaticOrder base;
    __host__ __device__ void init(int M_, int N_, int G_, int c_) { base.init(M_, N_, G_, c_); }
    __host__ __device__ bool next(int i, Unit& u) const { if (!base.next(i >> 1, u)) return false; u.kind = i & 1; return true; }
    __device__ __forceinline__ void a_ready(const Unit&) const {}
    __device__ __forceinline__ void done(const Unit&) const {}
};


template <bool TRACK> struct EpiStore {
    static constexpr bool PERM = true, AFTER_DRAIN = false, CHAIN = false;
    bf16_t* O; int ldc; int qt0, qt1, kt1; float qscale; unsigned* nrm;
    unsigned char* GQ = nullptr; int gt0 = 1 << 30;
    __device__ __forceinline__ void operator()(const f32x4 (&acc)[2][2][4][2], const Unit& u, int wr, int wc, int fr, int fq) const {
        const int row0 = u.pm * BM + wr * 64 + fr, col0 = u.pn * BM + wc * 32 + 8 * fq;
        if (u.pn >= gt0) {
            const int gc0 = (u.pn - gt0) * BM + wc * 32 + 8 * fq;
#pragma unroll
            for (int ai = 0; ai < 2; ++ai)
#pragma unroll
                for (int m = 0; m < 4; ++m) { unsigned char* rowp = GQ + (size_t)(row0 + ai * HALF + m * 16) * 2048 + gc0;
#pragma unroll
                    for (int bj = 0; bj < 2; ++bj) { unsigned wlo = 0u, whi = 0u;
#pragma unroll
                        for (int j = 0; j < 4; ++j) {
                            const float s0 = sigmoid_f(acc[ai][bj][m][0][j]) * 255.f, s1 = sigmoid_f(acc[ai][bj][m][1][j]) * 255.f;
                            const unsigned q0 = (unsigned)__builtin_fmaxf(__builtin_rintf(s0), 1.f), q1 = (unsigned)__builtin_fmaxf(__builtin_rintf(s1), 1.f);
                            wlo |= q0 << (8 * j); whi |= q1 << (8 * j); }
                        *(u32x2*)(rowp + bj * HALF) = (u32x2){wlo, whi}; } }
            return;
        }
        const bool isq = (u.pn >= qt0 && u.pn < qt1), isk = (u.pn >= qt1 && u.pn < kt1);
        const float sc = isq ? qscale : 1.f;
        float rmax = 0.f;
#pragma unroll
        for (int ai = 0; ai < 2; ++ai)
#pragma unroll
            for (int m = 0; m < 4; ++m) { bf16_t* rowp = O + (size_t)(row0 + ai * HALF + m * 16) * ldc + col0;
#pragma unroll
                for (int bj = 0; bj < 2; ++bj) { const f32x4 v0 = acc[ai][bj][m][0] * sc, v1 = acc[ai][bj][m][1] * sc;
                    u32x4 w; w.x = cvtpk(v0[0], v0[1]); w.y = cvtpk(v0[2], v0[3]); w.z = cvtpk(v1[0], v1[1]); w.w = cvtpk(v1[2], v1[3]);
                    *(u32x4*)(rowp + bj * HALF) = w;
                    if (TRACK && (isq || isk)) { float q = (v0[0] * v0[0] + v0[1] * v0[1]) + (v0[2] * v0[2] + v0[3] * v0[3]) + (v1[0] * v1[0] + v1[1] * v1[1]) + (v1[2] * v1[2] + v1[3] * v1[3]);
                        q += __shfl_xor(q, 16); q += __shfl_xor(q, 32); rmax = __builtin_fmaxf(rmax, q); } } }
        if (TRACK && (isq || isk)) {
#pragma unroll
            for (int o = 1; o < 16; o <<= 1) rmax = __builtin_fmaxf(rmax, __shfl_xor(rmax, o));
            if (fr == 0 && fq == 0) (void)__hip_atomic_fetch_max(nrm + (isk ? 64 : 0), __float_as_uint(rmax), __ATOMIC_RELAXED, __HIP_MEMORY_SCOPE_AGENT);
        }
    }
};
struct EpiMixChain {
    static constexpr bool PERM = true, AFTER_DRAIN = false, CHAIN = true;
    const unsigned char* GQ; bf16_t* T;
    __device__ __forceinline__ void operator()(f32x4 (&acc)[2][2][4][2], const Unit& u, int wr, int wc, int fr, int fq) const {
        const int row0 = u.pm * BM + wr * 64 + fr, col0 = u.pn * BM + wc * 32 + 8 * fq;
        if (u.kind == 0) {
#pragma unroll
            for (int ai = 0; ai < 2; ++ai)
#pragma unroll
                for (int m = 0; m < 4; ++m) { const unsigned char* gp = GQ + (size_t)(row0 + ai * HALF + m * 16) * 2048 + col0;
#pragma unroll
                    for (int bj = 0; bj < 2; ++bj) {
                        const u32x2 qa = *(const u32x2*)(gp + bj * HALF), qb = *(const u32x2*)(gp + 1024 + bj * HALF);
#pragma unroll
                        for (int j = 0; j < 4; ++j) {
                            const float r0 = (float)((qa.x >> (8 * j)) & 0xffu) * __builtin_amdgcn_rcpf((float)((qb.x >> (8 * j)) & 0xffu));
                            const float r1 = (float)((qa.y >> (8 * j)) & 0xffu) * __builtin_amdgcn_rcpf((float)((qb.y >> (8 * j)) & 0xffu));
                            acc[ai][bj][m][0][j] *= r0; acc[ai][bj][m][1][j] *= r1; } }
                    if (m == 3) asm volatile("" ::: "memory"); }
        } else {
#pragma unroll
            for (int ai = 0; ai < 2; ++ai)
#pragma unroll
                for (int m = 0; m < 4; ++m) { const size_t row = (size_t)(row0 + ai * HALF + m * 16);
#pragma unroll
                    for (int bj = 0; bj < 2; ++bj) {
                        const u32x2 qb = *(const u32x2*)(GQ + row * 2048 + 1024 + col0 + bj * HALF);
                        const f32x4 a0 = acc[ai][bj][m][0], a1 = acc[ai][bj][m][1];
                        float f0[4], f1[4];
#pragma unroll
                        for (int j = 0; j < 4; ++j) { f0[j] = (float)((qb.x >> (8 * j)) & 0xffu) * (1.f / 255.f) * a0[j]; f1[j] = (float)((qb.y >> (8 * j)) & 0xffu) * (1.f / 255.f) * a1[j]; }
                        u32x4 w; w.x = cvtpk(f0[0], f0[1]); w.y = cvtpk(f0[2], f0[3]); w.z = cvtpk(f1[0], f1[1]); w.w = cvtpk(f1[2], f1[3]);
                        *(u32x4*)(T + row * DM + col0 + bj * HALF) = w; }
                    if (m == 3) asm volatile("" ::: "memory"); }
        }
    }
};
struct EpiRes {
    static constexpr bool PERM = false, AFTER_DRAIN = false, CHAIN = false;
    const float* base; float* out; const float* gate;
    __device__ __forceinline__ void operator()(const f32x4 (&acc)[2][2][4][2], const Unit& u, int wr, int wc, int fr, int fq) const {
        const int col0 = u.pn * BM + wc * 32 + 4 * fq; const int b = (u.pm * BM) / SEQ;
        f32x4 gv[2][2];
#pragma unroll
        for (int bj = 0; bj < 2; ++bj)
#pragma unroll
            for (int n = 0; n < 2; ++n) gv[bj][n] = *(const f32x4*)(gate + (size_t)b * 6144 + col0 + bj * HALF + n * 16);
#pragma unroll
        for (int ai = 0; ai < 2; ++ai)
#pragma unroll
            for (int m = 0; m < 4; ++m) { const size_t off = (size_t)(u.pm * BM + ai * HALF + wr * 64 + m * 16 + fr) * DM + col0;
#pragma unroll
                for (int bj = 0; bj < 2; ++bj)
#pragma unroll
                    for (int n = 0; n < 2; ++n) { const f32x4 bs = *(const f32x4*)(base + off + bj * HALF + n * 16);
                        *(f32x4*)(out + off + bj * HALF + n * 16) = bs + gv[bj][n] * acc[ai][bj][m][n]; } }
    }
};
template <int MODE> struct EpiResNorm {
    static constexpr bool PERM = false, AFTER_DRAIN = false, CHAIN = false;
    const float* base; float* out; const float* gate; const float* gn; const float* sc; const float* sh; bf16_t* H2; float* rss; unsigned* cnt; _Float16* x1h;
    __device__ __forceinline__ void operator()(f32x4 (&acc)[2][2][4][2], const Unit& u, int wr, int wc, int fr, int fq) const {
        const int col0 = u.pn * BM + wc * 32 + 4 * fq; const int b = (u.pm * BM) / SEQ;
        const int rowb = u.pm * BM + wr * 64 + fr;
        {
            f32x4 gv[2][2];
#pragma unroll
            for (int bj = 0; bj < 2; ++bj)
#pragma unroll
                for (int n = 0; n < 2; ++n) gv[bj][n] = *(const f32x4*)(gate + (size_t)b * 6144 + col0 + bj * HALF + n * 16);
            if constexpr (MODE == 1) {
                float rsum[2][4];
#pragma unroll
                for (int q = 0; q < 4; ++q) { const int ai = q >> 1, m0 = 2 * (q & 1);
                    h16x4 pre[2][2][2];
#pragma unroll
                    for (int mm = 0; mm < 2; ++mm) { const size_t off = (size_t)(rowb + ai * HALF + (m0 + mm) * 16) * DM + col0;
#pragma unroll
                        for (int bj = 0; bj < 2; ++bj)
#pragma unroll
                            for (int n = 0; n < 2; ++n) pre[mm][bj][n] = *(const h16x4*)(x1h + off + bj * HALF + n * 16); }
#pragma unroll
                    for (int mm = 0; mm < 2; ++mm) { const int m = m0 + mm; float s = 0.f;
#pragma unroll
                        for (int bj = 0; bj < 2; ++bj)
#pragma unroll
                            for (int n = 0; n < 2; ++n) { const f32x4 v = __builtin_convertvector(pre[mm][bj][n], f32x4) + gv[bj][n] * acc[ai][bj][m][n]; acc[ai][bj][m][n] = v;
                                s += (v[0] * v[0] + v[1] * v[1]) + (v[2] * v[2] + v[3] * v[3]); }
                        s += __shfl_xor(s, 16); s += __shfl_xor(s, 32); rsum[ai][m] = s; }
                    asm volatile("" ::: "memory"); }
                if (fq == 0) {
#pragma unroll
                    for (int ai = 0; ai < 2; ++ai)
#pragma unroll
                        for (int m = 0; m < 4; ++m) (void)__hip_atomic_fetch_add(rss + rowb + ai * HALF + m * 16, rsum[ai][m], __ATOMIC_RELAXED, __HIP_MEMORY_SCOPE_AGENT);
                }
            } else {
#pragma unroll
            for (int ai = 0; ai < 2; ++ai)
#pragma unroll
                for (int m = 0; m < 4; ++m) { const int row = rowb + ai * HALF + m * 16; const size_t off = (size_t)row * DM + col0; float s = 0.f;
#pragma unroll
                    for (int bj = 0; bj < 2; ++bj)
#pragma unroll
                        for (int n = 0; n < 2; ++n) { f32x4 bs; if (MODE == 0) bs = *(const f32x4*)(base + off + bj * HALF + n * 16); else bs = __builtin_convertvector(*(const h16x4*)(x1h + off + bj * HALF + n * 16), f32x4);
                            const f32x4 v = bs + gv[bj][n] * acc[ai][bj][m][n];
                            acc[ai][bj][m][n] = v; if (MODE == 0) *(h16x4*)(x1h + off + bj * HALF + n * 16) = __builtin_convertvector(v, h16x4);
                            s += (v[0] * v[0] + v[1] * v[1]) + (v[2] * v[2] + v[3] * v[3]); }
                    s += __shfl_xor(s, 16); s += __shfl_xor(s, 32);
                    if (fq == 0) (void)__hip_atomic_fetch_add(rss + row, s, __ATOMIC_RELAXED, __HIP_MEMORY_SCOPE_AGENT); }
        }
            }
        asm volatile("s_waitcnt vmcnt(0)" ::: "memory");
        if (fr == 0 && fq == 0) {
            unsigned* cp = cnt + 16 * u.pm;
            (void)__hip_atomic_fetch_add(cp, 1u, __ATOMIC_RELAXED, __HIP_MEMORY_SCOPE_AGENT);
            unsigned sp = 0;
            while (__hip_atomic_load(cp, __ATOMIC_RELAXED, __HIP_MEMORY_SCOPE_AGENT) < 32u) { __builtin_amdgcn_s_sleep(2); if (++sp > (1u << 22)) break; }
        }
        asm volatile("" ::: "memory");
        f32x4 gf[2][2], scv[2][2], shv[2][2];
#pragma unroll
        for (int bj = 0; bj < 2; ++bj)
#pragma unroll
            for (int n = 0; n < 2; ++n) { gf[bj][n] = *(const f32x4*)(gn + col0 + bj * HALF + n * 16);
                if (MODE == 0) { scv[bj][n] = *(const f32x4*)(sc + (size_t)b * 6144 + col0 + bj * HALF + n * 16); shv[bj][n] = *(const f32x4*)(sh + (size_t)b * 6144 + col0 + bj * HALF + n * 16);
                    gf[bj][n] = gf[bj][n] * (scv[bj][n] + 1.f); } }
        float rsv[2][4];
#pragma unroll
        for (int ai = 0; ai < 2; ++ai)
#pragma unroll
            for (int m = 0; m < 4; ++m) rsv[ai][m] = __hip_atomic_load(rss + rowb + ai * HALF + m * 16, __ATOMIC_RELAXED, __HIP_MEMORY_SCOPE_AGENT);
#pragma unroll
        for (int ai = 0; ai < 2; ++ai)
#pragma unroll
            for (int m = 0; m < 4; ++m) { const int row = rowb + ai * HALF + m * 16; const size_t off = (size_t)row * DM + col0;
                const float rstd = __builtin_amdgcn_rsqf(rsv[ai][m] * (1.f / DM) + EPS);
#pragma unroll
                for (int bj = 0; bj < 2; ++bj)
#pragma unroll
                    for (int n = 0; n < 2; ++n) {
                        if (MODE == 0) { const f32x4 hv = acc[ai][bj][m][n] * rstd * gf[bj][n] + shv[bj][n];
                            u32x2 o; o.x = cvtpk(hv[0], hv[1]); o.y = cvtpk(hv[2], hv[3]); *(u32x2*)(H2 + off + bj * HALF + n * 16) = o; }
                        else *(f32x4*)(out + off + bj * HALF + n * 16) = acc[ai][bj][m][n] * rstd * gf[bj][n]; } }
    }
};
struct EpiSwiglu {
    static constexpr bool PERM = true, AFTER_DRAIN = false, CHAIN = false;
    bf16_t* H;
    __device__ __forceinline__ void operator()(const f32x4 (&acc)[2][2][4][2], const Unit& u, int wr, int wc, int fr, int fq) const {
        const int row0 = u.pm * BM + wr * 64 + fr, col0 = u.pn * HALF + wc * 32 + 8 * fq;
#pragma unroll
        for (int ai = 0; ai < 2; ++ai)
#pragma unroll
            for (int m = 0; m < 4; ++m) { bf16_t* rowp = H + (size_t)(row0 + ai * HALF + m * 16) * FF + col0;
                const f32x4 g0 = acc[ai][0][m][0], g1 = acc[ai][0][m][1], u0 = acc[ai][1][m][0], u1 = acc[ai][1][m][1];
                u32x4 w; w.x = cvtpk(silu_f(g0[0]) * u0[0], silu_f(g0[1]) * u0[1]); w.y = cvtpk(silu_f(g0[2]) * u0[2], silu_f(g0[3]) * u0[3]);
                w.z = cvtpk(silu_f(g1[0]) * u1[0], silu_f(g1[1]) * u1[1]); w.w = cvtpk(silu_f(g1[2]) * u1[2], silu_f(g1[3]) * u1[3]);
                *(u32x4*)rowp = w; }
    }
};

template <class Epi, class Sched, bool ALIGN_EPI = false, bool SP2 = false>
__device__ __forceinline__ void gemm_phase(LAS unsigned char* lds, const Gemm g, const Sched& S, const Epi& E) {
    int tid = threadIdx.x; asm volatile("" : "+v"(tid));
    const int wid = __builtin_amdgcn_readfirstlane(tid >> 6), lane = tid & 63, wr = wid >> 2, wc = wid & 3, fr = lane & 15, fq = lane >> 4;
    const int K = g.K, nt = K / BK;
    unsigned voffA[2], voffB[2];
#pragma unroll
    for (int i = 0; i < 2; ++i) { int R, C; stage_rc(tid * 16 + i * 8192, R, C); const int Rb = Epi::PERM ? ((R & ~31) + perm32(R & 31)) : R;
        voffA[i] = (unsigned)(R * K + C) * 2u; voffB[i] = (unsigned)(Rb * K + C) * 2u; }
    const size_t kstep = (size_t)(BK * 2);
    const size_t hstep = (size_t)HALF * K * 2;
    const size_t tstep = 2 * hstep;
    const unsigned ldsw = (unsigned)wid * 1024u;
    const int aoff = lds_byte(wr * 64 + fr, fq * 8), boff = lds_byte(wc * 32 + fr, fq * 8);
#define PG8_SA(b, h) (((b) * 2 + (h)) * HTB)
#define PG8_SB(b, h) ((4 + (b) * 2 + (h)) * HTB)
#define PG8_STAGE(bufoff, gbase, voff) do { _Pragma("unroll") for (int _i = 0; _i < 2; ++_i) \
        __builtin_amdgcn_global_load_lds((const unsigned*)((const char*)(gbase) + (voff)[_i]), (LAS unsigned*)(lds + (bufoff) + ldsw + _i * 8192), 16, 0, 0); } while (0)
#define PG8_LDA(dst, b, h) do { _Pragma("unroll") for (int m = 0; m < 4; ++m) _Pragma("unroll") for (int k = 0; k < 2; ++k) dst[m][k] = *(const LAS bf16x8*)(lds + PG8_SA(b, h) + aoff + m * 2048 + k * 1024); } while (0)
#define PG8_LDB(dst, b, h) do { _Pragma("unroll") for (int n = 0; n < 2; ++n) _Pragma("unroll") for (int k = 0; k < 2; ++k) dst[n][k] = *(const LAS bf16x8*)(lds + PG8_SB(b, h) + boff + n * 2048 + k * 1024); } while (0)
#define PG8_MMA(ai, bj, At, Bt) do { __builtin_amdgcn_s_setprio(1); _Pragma("unroll") for (int m = 0; m < 4; ++m) _Pragma("unroll") for (int n = 0; n < 2; ++n) _Pragma("unroll") for (int k = 0; k < 2; ++k) \
        acc[ai][bj][m][n] = __builtin_amdgcn_mfma_f32_16x16x32_bf16(Bt[n][k], At[m][k], acc[ai][bj][m][n], 0, 0, 0); __builtin_amdgcn_s_setprio(0); } while (0)
#define PG8_WAIT_V(n) asm volatile("s_waitcnt vmcnt(" #n ")" ::: "memory")
#define PG8_WAIT_L(n) asm volatile("s_waitcnt lgkmcnt(" #n ")" ::: "memory")
#define PG8_BAR __builtin_amdgcn_s_barrier()
#define PG8_SCHED __builtin_amdgcn_sched_barrier(0)
    Unit cur, nxt; int ui = 0;
    if (!S.next(0, cur)) return;
    f32x4 acc[2][2][4][2];
#pragma unroll
    for (int a = 0; a < 2; ++a)
#pragma unroll
        for (int b = 0; b < 2; ++b)
#pragma unroll
            for (int m = 0; m < 4; ++m)
#pragma unroll
                for (int n = 0; n < 2; ++n) acc[a][b][m][n] = (f32x4){0.f, 0.f, 0.f, 0.f};
    bf16x8 At[4][2], B0[2][2], B1[2][2];
    const char* cA = (const char*)(cur.kind ? g.A1 : g.A) + (size_t)cur.pm * tstep; const char* cB = (const char*)(cur.kind ? g.Bt1 : g.Bt) + (size_t)cur.pn * tstep;
    S.a_ready(cur);
    if constexpr (SP2) {
        PG8_STAGE(PG8_SB(0, 0), cB, voffB); PG8_STAGE(PG8_SB(0, 1), cB + hstep, voffB); PG8_STAGE(PG8_SA(0, 0), cA, voffA); PG8_STAGE(PG8_SA(0, 1), cA + hstep, voffA);
        if (wr == 1) PG8_BAR;
        PG8_WAIT_V(2); PG8_BAR;
        PG8_STAGE(PG8_SB(1, 0), cB + kstep, voffB); PG8_STAGE(PG8_SA(1, 0), cA + kstep, voffA); PG8_STAGE(PG8_SB(1, 1), cB + hstep + kstep, voffB);
        PG8_WAIT_V(6); PG8_BAR;
    } else {
        PG8_STAGE(PG8_SB(0, 0), cB, voffB); PG8_STAGE(PG8_SA(0, 0), cA, voffA); PG8_STAGE(PG8_SB(0, 1), cB + hstep, voffB); PG8_STAGE(PG8_SA(0, 1), cA + hstep, voffA);
        if (wr == 1) PG8_BAR;
        PG8_WAIT_V(4); PG8_BAR;
        PG8_STAGE(PG8_SB(1, 0), cB + kstep, voffB); PG8_STAGE(PG8_SA(1, 0), cA + kstep, voffA); PG8_STAGE(PG8_SB(1, 1), cB + hstep + kstep, voffB);
        PG8_WAIT_V(6); PG8_BAR;
    }
    for (;;) {
        const bool has_next = S.next(ui + 1, nxt);
        const char* nA = has_next ? (const char*)(nxt.kind ? g.A1 : g.A) + (size_t)nxt.pm * tstep : cA; const char* nB = has_next ? (const char*)(nxt.kind ? g.Bt1 : g.Bt) + (size_t)nxt.pn * tstep : cB;
        for (int t = 0; t < nt; t += 2) {
            const bool last = (t == nt - 2);
            const char* a1 = cA + (size_t)(t + 1) * kstep;
            const char* a2 = last ? nA : cA + (size_t)(t + 2) * kstep; const char* b2 = last ? nB : cB + (size_t)(t + 2) * kstep;
            const char* a3 = a2 + kstep; const char* b3 = b2 + kstep;
            if (last && has_next) S.a_ready(nxt);
            if constexpr (SP2) {
            PG8_LDB(B0, 0, 0); PG8_LDB(B1, 0, 1); PG8_SCHED; PG8_LDA(At, 0, 0); PG8_STAGE(PG8_SA(1, 1), a1 + hstep, voffA);
            PG8_WAIT_V(8); PG8_WAIT_L(0); PG8_BAR; PG8_MMA(0, 0, At, B0); PG8_MMA(0, 1, At, B1); PG8_BAR; PG8_SCHED;
            PG8_LDA(At, 0, 1); PG8_STAGE(PG8_SB(0, 0), b2, voffB); PG8_STAGE(PG8_SB(0, 1), b2 + hstep, voffB); PG8_STAGE(PG8_SA(0, 0), a2, voffA);
            PG8_WAIT_V(8); PG8_WAIT_L(0); PG8_BAR; PG8_MMA(1, 0, At, B0); PG8_MMA(1, 1, At, B1); PG8_BAR; PG8_SCHED;
            PG8_LDB(B0, 1, 0); PG8_LDB(B1, 1, 1); PG8_SCHED; PG8_LDA(At, 1, 0); PG8_STAGE(PG8_SA(0, 1), a2 + hstep, voffA);
            PG8_WAIT_V(8); PG8_WAIT_L(0); PG8_BAR; PG8_MMA(0, 0, At, B0); PG8_MMA(0, 1, At, B1); PG8_BAR; PG8_SCHED;
            PG8_LDA(At, 1, 1); PG8_STAGE(PG8_SB(1, 0), b3, voffB); PG8_STAGE(PG8_SB(1, 1), b3 + hstep, voffB); PG8_STAGE(PG8_SA(1, 0), a3, voffA);
            PG8_WAIT_V(8); PG8_WAIT_L(0); PG8_BAR; PG8_MMA(1, 0, At, B0); PG8_MMA(1, 1, At, B1); PG8_BAR; PG8_SCHED;
            } else {
            PG8_LDB(B0, 0, 0); PG8_SCHED; PG8_LDA(At, 0, 0); PG8_STAGE(PG8_SA(1, 1), a1 + hstep, voffA);
            PG8_WAIT_L(8); PG8_BAR; PG8_WAIT_L(0); PG8_MMA(0, 0, At, B0); PG8_BAR; PG8_SCHED;
            PG8_LDB(B1, 0, 1); PG8_STAGE(PG8_SB(0, 0), b2, voffB);
            PG8_BAR; PG8_WAIT_L(0); PG8_MMA(0, 1, At, B1); PG8_BAR;
            PG8_LDA(At, 0, 1); PG8_STAGE(PG8_SA(0, 0), a2, voffA);
            PG8_BAR; PG8_WAIT_L(0); PG8_MMA(1, 0, At, B0); PG8_BAR; PG8_SCHED;
            PG8_STAGE(PG8_SB(0, 1), b2 + hstep, voffB);
            PG8_WAIT_V(6); PG8_BAR; PG8_MMA(1, 1, At, B1); PG8_BAR;
            PG8_LDB(B0, 1, 0); PG8_SCHED; PG8_LDA(At, 1, 0); PG8_STAGE(PG8_SA(0, 1), a2 + hstep, voffA);
            PG8_WAIT_L(8); PG8_BAR; PG8_WAIT_L(0); PG8_MMA(0, 0, At, B0); PG8_BAR; PG8_SCHED;
            PG8_LDB(B1, 1, 1); PG8_STAGE(PG8_SB(1, 0), b3, voffB);
            PG8_BAR; PG8_WAIT_L(0); PG8_MMA(0, 1, At, B1); PG8_BAR;
            PG8_LDA(At, 1, 1); PG8_STAGE(PG8_SA(1, 0), a3, voffA);
            PG8_BAR; PG8_WAIT_L(0); PG8_MMA(1, 0, At, B0); PG8_BAR; PG8_SCHED;
            PG8_STAGE(PG8_SB(1, 1), b3 + hstep, voffB);
            PG8_WAIT_V(6); PG8_BAR; PG8_MMA(1, 1, At, B1); PG8_BAR;
            }
        }
        if constexpr (ALIGN_EPI) { if (wr == 0) PG8_BAR; }
        if constexpr (!Epi::AFTER_DRAIN) { E(acc, cur, wr, wc, fr, fq); S.done(cur); }
        if (!has_next) break;
        if constexpr (Epi::CHAIN) {
            const float keep = (cur.kind == 0) ? 1.f : 0.f;
#pragma unroll
            for (int a = 0; a < 2; ++a)
#pragma unroll
                for (int b = 0; b < 2; ++b)
#pragma unroll
                    for (int m = 0; m < 4; ++m)
#pragma unroll
                        for (int n = 0; n < 2; ++n) acc[a][b][m][n] *= keep;
        } else {
#pragma unroll
        for (int a = 0; a < 2; ++a)
#pragma unroll
            for (int b = 0; b < 2; ++b)
#pragma unroll
                for (int m = 0; m < 4; ++m)
#pragma unroll
                    for (int n = 0; n < 2; ++n) acc[a][b][m][n] = (f32x4){0.f, 0.f, 0.f, 0.f};
        }
        cur = nxt; cA = nA; cB = nB; ++ui;
        if constexpr (ALIGN_EPI) { if (wr == 1) PG8_BAR; }
    }
    PG8_WAIT_V(0);
    if constexpr (!ALIGN_EPI) { if (wr == 0) PG8_BAR; }
    PG8_BAR;
#undef PG8_SA
#undef PG8_SB
#undef PG8_STAGE
#undef PG8_LDA
#undef PG8_LDB
#undef PG8_MMA
#undef PG8_WAIT_V
#undef PG8_WAIT_L
#undef PG8_BAR
#undef PG8_SCHED
}
}


#define XB_TMO      128
#define XB_XCNT(j)  (256  + 64 * (j))
#define XB_XSUB(j)  (1280 + 64 * (j))
#define XB_XGEN(j)  (2304 + 64 * (j))
#define XB_TOP      3328
#define XB_TOPGEN   3392
#define XCD_BAR_WORDS 3456
#define XB_SPIN_CAP (1u << 20)
__device__ __forceinline__ unsigned xb_ld(unsigned* p)              { return __hip_atomic_load(p, __ATOMIC_RELAXED, __HIP_MEMORY_SCOPE_AGENT); }
__device__ __forceinline__ unsigned xb_add(unsigned* p, unsigned v) { return __hip_atomic_fetch_add(p, v, __ATOMIC_RELAXED, __HIP_MEMORY_SCOPE_AGENT); }
__device__ __forceinline__ unsigned xb_xcc_id() { return (unsigned)__builtin_amdgcn_s_getreg((3 << 11) | 20) & 0xFu; }
#define XB_SPIN(cond, bar) do { unsigned _sp = 0; while (cond) { __builtin_amdgcn_s_sleep(1); \
    if ((++_sp & 255u) == 0u) { if (xb_ld(&(bar)[XB_TMO])) break; if (_sp > XB_SPIN_CAP) { atomicAdd(&(bar)[XB_TMO], 1u); break; } } } } while (0)
struct XcdBarrier { unsigned* bar; unsigned x; volatile LAS unsigned* st; };
__device__ __forceinline__ XcdBarrier xcd_barrier_post(unsigned* bar, volatile LAS unsigned* st) {
    XcdBarrier b; b.bar = bar; b.x = xb_xcc_id(); b.st = st;
    if (threadIdx.x == 0) (void)xb_add(&bar[XB_XCNT(b.x)], 1u);
    return b;
}
__device__ __forceinline__ void xcd_barrier_complete(unsigned* bar, unsigned x, unsigned& nloc, unsigned& nx) {
    const unsigned G = gridDim.x * gridDim.y * gridDim.z;
    unsigned sum, cnt, mine, sp = 0u;
    for (;;) {
        sum = 0u; cnt = 0u; mine = 0u;
#pragma unroll
        for (unsigned j = 0; j < 16; ++j) { const unsigned c = xb_ld(&bar[XB_XCNT(j)]); sum += c; cnt += (c > 0u) ? 1u : 0u; mine = (j == x) ? c : mine; }
        if (sum == G) break;
        __builtin_amdgcn_s_sleep(1);
        if ((++sp & 255u) == 0u) { if (xb_ld(&bar[XB_TMO])) break; if (sp > XB_SPIN_CAP) { atomicAdd(&bar[XB_TMO], 1u); break; } }
    }
    nloc = mine > 0u ? mine : 1u; nx = cnt > 0u ? cnt : 1u;
}
__device__ __forceinline__ void xcd_barrier(const XcdBarrier& b) {
    asm volatile("s_waitcnt vmcnt(0)" ::: "memory");
    __syncthreads();
    if (threadIdx.x == 0) {
        unsigned* bar = b.bar;
        __builtin_amdgcn_s_waitcnt(0);
        unsigned nloc = b.st[0], nx = b.st[1];
        if (nloc == 0u) { xcd_barrier_complete(bar, b.x, nloc, nx); b.st[0] = nloc; b.st[1] = nx; }
        const unsigned old = xb_add(&bar[XB_XSUB(b.x)], 1u);
        const unsigned gen = old / nloc;
        if (old + 1u == (gen + 1u) * nloc) {
            __builtin_amdgcn_fence(__ATOMIC_RELEASE, "agent");
            asm volatile("s_waitcnt vmcnt(0)" ::: "memory");
            const unsigned og = xb_add(&bar[XB_TOP], 1u);
            const unsigned tg = og / nx;
            if (og + 1u == (tg + 1u) * nx) xb_add(&bar[XB_TOPGEN], 1u);
            else XB_SPIN(xb_ld(&bar[XB_TOPGEN]) == tg, bar);
            __builtin_amdgcn_fence(__ATOMIC_ACQUIRE, "agent");
            xb_add(&bar[XB_XGEN(b.x)], 1u);
            asm volatile("s_waitcnt vmcnt(0)" ::: "memory");
        } else {
            XB_SPIN(xb_ld(&bar[XB_XGEN(b.x)]) == gen, bar);
            __builtin_amdgcn_fence(__ATOMIC_ACQUIRE, "agent");
            asm volatile("s_waitcnt vmcnt(0)" ::: "memory");
        }
    }
    __syncthreads();
}

struct Args {
    const float* x; const float* c; const float* w_ada; const float* b_ada; const float* g_mix; const float* w_in; const float* conv_w; const float* w_out_a;
    const float* lq1; const float* lk1; const float* lq2; const float* lk2; const float* subln_g; const float* w_out_b; const float* w_out; const float* g_ffn;
    const float* w_gate; const float* w_up; const float* w_down; const float* g_final;
    float* out; unsigned char* ws;
};

__device__ __forceinline__ void transpose_item(const float* W, int K, int N, bf16_t* WT, int k0, int n0, int drow0, LAS float* scr, int lane) {
#pragma unroll 8
    for (int i = 0; i < 32; ++i) { const int kk = 2 * i + (lane >> 5); scr[kk * 33 + (lane & 31)] = W[(size_t)(k0 + kk) * N + n0 + (lane & 31)]; }
    asm volatile("s_waitcnt lgkmcnt(0)" ::: "memory");
    const int c = lane & 7;
#pragma unroll
    for (int j = 0; j < 4; ++j) { const int n = (lane >> 3) + 8 * j; const LAS float* s = scr + (8 * c) * 33 + n;
        u32x4 o; o.x = cvtpk(s[0 * 33], s[1 * 33]); o.y = cvtpk(s[2 * 33], s[3 * 33]); o.z = cvtpk(s[4 * 33], s[5 * 33]); o.w = cvtpk(s[6 * 33], s[7 * 33]);
        *(u32x4*)(WT + (size_t)(drow0 + n) * K + k0 + 8 * c) = o; }
    asm volatile("s_waitcnt lgkmcnt(0)" ::: "memory");
}

constexpr int AT_KROW = 272, AT_VROW = 144;
constexpr int AT_KBUF = 64 * AT_KROW, AT_VBUF = 128 * AT_VROW;
constexpr int AT_V0 = 2 * AT_KBUF, AT_G = 73728;
#define MFMA32(a, b, c) __builtin_amdgcn_mfma_f32_32x32x16_bf16((a), (b), (c), 0, 0, 0)
__device__ __forceinline__ void qk_half(f32x16& s, const LAS unsigned char* kq_, const bf16x8 (&qf)[4]) {
    s = f32x16{};
#pragma unroll
    for (int ks = 0; ks < 4; ++ks) { const bf16x8 a = *(const LAS bf16x8*)(kq_ + ks * 32); s = MFMA32(a, qf[ks], s); }
}
__device__ __forceinline__ void pv_half(f32x16 (&o)[4], const LAS unsigned char* vc_, const bf16x8 (&pf)[2]) {
#pragma unroll
    for (int bl = 0; bl < 4; ++bl)
#pragma unroll
        for (int s2 = 0; s2 < 2; ++s2) { const bf16x8 a = *(const LAS bf16x8*)(vc_ + bl * 32 * AT_VROW + s2 * 32); o[bl] = MFMA32(a, pf[s2], o[bl]); }
}
template <bool DIAG, int KB> __device__ __forceinline__ void sm_half(f32x16& s, bf16x8 (&pf)[2], float& mref, float& lrun, float& alpha, float slope2, float dq) {
    float mx = -1e30f;
#pragma unroll
    for (int i = 0; i < 16; ++i) { const float ci = (float)(16 * (i >> 3) + (i & 7) + 32 * KB);
        if (DIAG) s[i] = __builtin_fmaf(-slope2, __builtin_fabsf(dq - ci), s[i]);
        else if (ci != 0.f) s[i] = __builtin_fmaf(slope2, ci, s[i]);
        mx = __builtin_fmaxf(mx, s[i]); }
    const float A = DIAG ? 0.f : -slope2 * dq;
    { const auto rr = __builtin_amdgcn_permlane32_swap(__float_as_uint(mx), __float_as_uint(mx), false, false);
      mx = __builtin_fmaxf(__uint_as_float(rr[0]), __uint_as_float(rr[1])) + A; }
    const float mnew = (mx > mref + 6.f) ? mx : mref;
    alpha = __builtin_amdgcn_exp2f(mref - mnew);
    mref = mnew;
    const float off = A - mnew;
    float ps = 0.f;
#pragma unroll
    for (int i = 0; i < 16; ++i) { s[i] = __builtin_amdgcn_exp2f(s[i] + off); ps += s[i]; }
    lrun = lrun * alpha + ps;
    u32x4 p;
    p.x = cvtpk(s[0], s[1]); p.y = cvtpk(s[2], s[3]); p.z = cvtpk(s[4], s[5]); p.w = cvtpk(s[6], s[7]); pf[0] = __builtin_bit_cast(bf16x8, p);
    p.x = cvtpk(s[8], s[9]); p.y = cvtpk(s[10], s[11]); p.z = cvtpk(s[12], s[13]); p.w = cvtpk(s[14], s[15]); pf[1] = __builtin_bit_cast(bf16x8, p);
}
__device__ __forceinline__ const LAS unsigned char* hf_addr(int g, const LAS unsigned char* kq_, const LAS unsigned char* vc_) {
    return g < 4 ? kq_ + g * 32 : vc_ + ((g - 4) >> 1) * 32 * AT_VROW + ((g - 4) & 1) * 32;
}
__device__ __forceinline__ float fma_negabs(float nslope, float d, float s) { float r; asm("v_fma_f32 %0, %1, |%2|, %3" : "=v"(r) : "v"(nslope), "v"(d), "v"(s)); return r; }
template <int KB, bool NEXT> __device__ __forceinline__ void fused_half(f32x16& SQ, f32x16& SS, bf16x8 (&PS)[2], const bf16x8 (&PP)[2], f32x16 (&o)[4], const bf16x8 (&qf)[4], f32x16& negm,
                                                          const LAS unsigned char* kq_, const LAS unsigned char* vc_, float& mref, float& lrun, float& alpha, float nslope2, float dqm,
                                                          bf16x8& f0, bf16x8& f1, const LAS unsigned char* nkq_) {
    float mx = -3.0e38f, ps = 0.f;
    alpha = 1.f;
    bf16x8 fr[3];
    fr[0] = f0; fr[1] = f1;
    __builtin_amdgcn_sched_barrier(0);
#pragma unroll
    for (int g = 0; g < 12; ++g) {
        if (g + 2 < 12) fr[(g + 2) % 3] = *(const LAS bf16x8*)hf_addr(g + 2, kq_, vc_);
        else if (NEXT) { if (g == 10) f0 = *(const LAS bf16x8*)(nkq_); else f1 = *(const LAS bf16x8*)(nkq_ + 32); }
        if (g < 4) SQ = (g == 0) ? MFMA32(fr[g % 3], qf[0], negm) : MFMA32(fr[g % 3], qf[g], SQ);
        else o[(g - 4) >> 1] = MFMA32(fr[g % 3], PP[(g - 4) & 1], o[(g - 4) >> 1]);
        if (g < 4) {
#pragma unroll
            for (int e2 = 0; e2 < 4; ++e2) { const int i = 4 * g + e2; const float ci = (float)(16 * (i >> 3) + (i & 7) + 32 * KB);
                SS[i] = fma_negabs(nslope2, dqm - ci, SS[i]);
                mx = __builtin_fmaxf(mx, SS[i]); }
            asm volatile("" : "+v"(SS), "+v"(mx));
        } else if (g == 4) {
            const auto rr = __builtin_amdgcn_permlane32_swap(__float_as_uint(mx), __float_as_uint(mx), false, false);
            mx = __builtin_fmaxf(__uint_as_float(rr[0]), __uint_as_float(rr[1]));
            if (__any(mx > 6.f)) {
                const float delta = (mx > 6.f) ? mx : 0.f;
                alpha = __builtin_amdgcn_exp2f(-delta); mref += delta;
#pragma unroll
                for (int i = 0; i < 16; ++i) { SS[i] -= delta; SQ[i] -= delta; negm[i] -= delta; }
            }
            asm volatile("" : "+v"(alpha), "+v"(mref), "+v"(SS));
        } else if (g < 9) {
#pragma unroll
            for (int e2 = 0; e2 < 4; ++e2) { const int i = 4 * (g - 5) + e2; SS[i] = __builtin_amdgcn_exp2f(SS[i]); ps += SS[i]; }
            asm volatile("" : "+v"(SS), "+v"(ps));
        } else if (g < 11) {
            const int j = g - 9; u32x4 p;
            p.x = cvtpk(SS[8 * j], SS[8 * j + 1]); p.y = cvtpk(SS[8 * j + 2], SS[8 * j + 3]); p.z = cvtpk(SS[8 * j + 4], SS[8 * j + 5]); p.w = cvtpk(SS[8 * j + 6], SS[8 * j + 7]);
            asm volatile("" : "+v"(p));
            PS[j] = __builtin_bit_cast(bf16x8, p);
        } else { lrun = lrun * alpha + ps; asm volatile("" : "+v"(lrun)); }
        __builtin_amdgcn_sched_barrier(0);
    }
}
#define AT_RESCALE(alpha_) do { if (__any((alpha_) != 1.f)) { _Pragma("unroll") for (int bl_ = 0; bl_ < 4; ++bl_) _Pragma("unroll") for (int i_ = 0; i_ < 16; ++i_) o[bl_][i_] *= (alpha_); } } while (0)

__device__ __forceinline__ void attn_unit(LAS unsigned char* lds, const bf16_t* __restrict__ PROJ, const bf16_t* __restrict__ VT, bf16_t* __restrict__ ATTNO,
                                          int b, int h, int qb, float lam, float slope2, float outscale, float skipD) {
    const int tid = threadIdx.x, lane = tid & 63, r = lane & 31, hh = lane >> 5;
    const int w = __builtin_amdgcn_readfirstlane(tid >> 6), c = w >> 2, wq = w & 3;
    const int tok0 = b * SEQ, q0 = 128 * qb;
    const int NT = 2 * qb + 2;
    int jmin = 0; { const float xj = ((float)(q0 - 63) - skipD) * (1.f / 64.f); if (xj > 0.f) jmin = (int)__builtin_ceilf(xj); if (jmin > NT - 2) jmin = NT - 2; }
    const int n = NT - jmin;
    const int k0 = (wq < 2) ? 1 : 0;
    bf16x8 qf[4];
    { const bf16_t* qp = PROJ + (size_t)(tok0 + q0 + 32 * wq + r) * PP + PC_Q + h * 128 + c * 64 + hh * 8;
#pragma unroll
      for (int ks = 0; ks < 4; ++ks) qf[ks] = *(const bf16x8*)(qp + ks * 16); }
    const char* kbU = (const char*)(PROJ + (size_t)tok0 * PP + PC_K + h * 128);
    const char* vbU = (const char*)(VT + (size_t)(h * 128) * VTP + tok0);
    unsigned koff0, voff0; int kdst0, vdst0;
    { const int row = tid >> 4, ch = tid & 15; const int rho = (row & ~12) | ((row & 8) >> 1) | ((row & 4) << 1);
      koff0 = (unsigned)(row * PP + ch * 8) * 2u; kdst0 = rho * AT_KROW + ch * 16; }
    { const int row = tid >> 3, ch = tid & 7;
      voff0 = (unsigned)(row * VTP + ch * 8) * 2u; vdst0 = AT_V0 + row * AT_VROW + ch * 16; }
#define KLD(i, tile) (*(const u32x4*)(kbU + ((size_t)(tile) * (64 * PP * 2) + (size_t)(i) * (32 * PP * 2)) + koff0))
#define VLD(i, tile) (*(const u32x4*)(vbU + ((size_t)(tile) * 128 + (size_t)(i) * ((size_t)64 * VTP * 2)) + voff0))
#define KDST(i) (kdst0 + (i) * 32 * AT_KROW)
#define VDST(i) (vdst0 + (i) * 64 * AT_VROW)
    u32x4 kst[2], vst[2];
#pragma unroll
    for (int i = 0; i < 2; ++i) kst[i] = KLD(i, NT - 1);
#pragma unroll
    for (int i = 0; i < 2; ++i) *(LAS u32x4*)(lds + KDST(i)) = kst[i];
    for (int i = tid; i < AT_VBUF / 16; i += NTHREADS) *(LAS u32x4*)(lds + AT_V0 + AT_VBUF + i * 16) = (u32x4){0u, 0u, 0u, 0u};
    asm volatile("" : "+v"(qf[0]), "+v"(qf[1]), "+v"(qf[2]), "+v"(qf[3]));
    __syncthreads();
    f32x16 o[4];
#pragma unroll
    for (int i = 0; i < 4; ++i) o[i] = f32x16{};
    f32x16 Se = f32x16{}, So = f32x16{};
    bf16x8 Pe[2], Po[2];
    Pe[0] = bf16x8{}; Pe[1] = bf16x8{}; Po[0] = bf16x8{}; Po[1] = bf16x8{};
    float mref = 0.f, lrun = 0.f;
    f32x16 negm = f32x16{};
    const int qpos = q0 + 32 * wq + r;
    const LAS unsigned char* kbase = lds + r * AT_KROW + c * 128 + hh * 16;
    const LAS unsigned char* vbase = lds + AT_V0 + r * AT_VROW + hh * 16;
#define AT_ITER(k) do { \
        const LAS unsigned char* kq_ = kbase + ((k) & 1) * AT_KBUF;              \
        bf16x8 f0_ = *(const LAS bf16x8*)(kq_), f1_ = *(const LAS bf16x8*)(kq_ + 32);     \
        if ((k) + 1 < n) { _Pragma("unroll") for (int i = 0; i < 2; ++i) kst[i] = KLD(i, NT - 2 - (k)); } \
        if ((k) < n)     { _Pragma("unroll") for (int i = 0; i < 2; ++i) vst[i] = VLD(i, NT - 1 - (k)); } \
        const LAS unsigned char* vc_ = vbase + (((k) + 1) & 1) * AT_VBUF;        \
        const float dqP = (float)(qpos - 64 * (NT - (k)) - 8 * hh);              \
        const float dqC = dqP + 64.f;                                            \
        const bool vK = ((k) >= k0 && (k) < n), vP = ((k) - 1 >= k0 && (k) - 1 < n);   \
        float alpha = 1.f; \
        fused_half<1, true>(Se, So, Po, Pe, o, qf, negm, kq_, vc_, mref, lrun, alpha, -slope2, vP ? dqP : 1e30f, f0_, f1_, kq_ + 32 * AT_KROW); \
        AT_RESCALE(alpha); \
        fused_half<0, false>(So, Se, Pe, Po, o, qf, negm, kq_ + 32 * AT_KROW, vc_ + 64, mref, lrun, alpha, -slope2, vK ? dqC : 1e30f, f0_, f1_, kq_); \
        AT_RESCALE(alpha); \
        if ((k) + 1 < n) { _Pragma("unroll") for (int i = 0; i < 2; ++i) *(LAS u32x4*)(lds + (((k) + 1) & 1) * AT_KBUF + KDST(i)) = kst[i]; } \
        if ((k) < n)     { _Pragma("unroll") for (int i = 0; i < 2; ++i) *(LAS u32x4*)(lds + ((k) & 1) * AT_VBUF + VDST(i)) = vst[i]; } \
        __syncthreads(); \
    } while (0)
    for (int k = 0; k <= n; ++k) AT_ITER(k);
#undef AT_ITER
#undef KLD
#undef VLD
#undef KDST
#undef VDST
    { const float lt = lrun + __shfl_xor(lrun, 32); const float inv = 1.f / lt;
#pragma unroll
      for (int bl = 0; bl < 4; ++bl)
#pragma unroll
          for (int i = 0; i < 16; ++i) o[bl][i] *= inv; }
    LAS float* X = (LAS float*)lds;
    if (c == 1) {
#pragma unroll
        for (int bl = 0; bl < 4; ++bl)
#pragma unroll
            for (int i = 0; i < 16; ++i) X[(wq * 64 + bl * 16 + i) * 64 + lane] = o[bl][i];
    }
    __syncthreads();
    if (c == 0) {
        float ss = 0.f;
#pragma unroll
        for (int bl = 0; bl < 4; ++bl)
#pragma unroll
            for (int i = 0; i < 16; ++i) { const float d = o[bl][i] - lam * X[(wq * 64 + bl * 16 + i) * 64 + lane]; o[bl][i] = d; ss += d * d; }
        ss += __shfl_xor(ss, 32);
        const float rstd = __builtin_amdgcn_rsqf(ss * (1.f / 128.f) + EPS) * outscale;
        const LAS float* gl = (const LAS float*)(lds + AT_G);
        bf16_t* op = ATTNO + (size_t)(tok0 + q0 + 32 * wq + r) * DA + h * 128 + 4 * hh;
#pragma unroll
        for (int bl = 0; bl < 4; ++bl)
#pragma unroll
            for (int g = 0; g < 4; ++g) { const int dv = 32 * bl + 8 * g;
                const f32x4 gg = *(const LAS f32x4*)(gl + dv + 4 * hh);
                u32x2 wv; wv.x = cvtpk(o[bl][4 * g] * rstd * gg[0], o[bl][4 * g + 1] * rstd * gg[1]); wv.y = cvtpk(o[bl][4 * g + 2] * rstd * gg[2], o[bl][4 * g + 3] * rstd * gg[3]);
                *(u32x2*)(op + dv) = wv; }
    }
    __syncthreads();
}

__global__ void __launch_bounds__(NTHREADS, 2) fwd_megakernel(Args a) {
    extern __shared__ __attribute__((aligned(16))) unsigned char lds_raw[];
    LAS unsigned char* lds = (LAS unsigned char*)lds_raw;
    cg::grid_group grid = cg::this_grid();
    const int tid = threadIdx.x, lane = tid & 63, wave = __builtin_amdgcn_readfirstlane(tid >> 6);
    const int G = gridDim.x, bx = blockIdx.x;
    const int vcu = (G % 8 == 0) ? (bx % 8) * (G / 8) + bx / 8 : bx;
    const int gw = vcu * 8 + wave, NGW = G * 8;
    unsigned char* ws = a.ws;
    float* MOD = (float*)(ws + WS_MOD); unsigned* CTL = (unsigned*)ws;
    bf16_t* WIN = (bf16_t*)(ws + WS_WIN); bf16_t* WOA = (bf16_t*)(ws + WS_WOA); bf16_t* WOB = (bf16_t*)(ws + WS_WOB); bf16_t* WOUT = (bf16_t*)(ws + WS_WOUT);
    bf16_t* WGU = (bf16_t*)(ws + WS_WGU); bf16_t* WD = (bf16_t*)(ws + WS_WD);
    bf16_t* XN = (bf16_t*)(ws + WS_XN); bf16_t* PROJ = (bf16_t*)(ws + WS_PROJ); bf16_t* HFF = (bf16_t*)(ws + WS_PROJ);
    unsigned char* GQ = ws + WS_PROJ + 160 * MiB;
    bf16_t* VT = (bf16_t*)(ws + WS_VT); bf16_t* CONVA = (bf16_t*)(ws + WS_CONVA); bf16_t* ATTNO = (bf16_t*)(ws + WS_ATTNO);
    volatile LAS unsigned* BST = (volatile LAS unsigned*)(lds + LDS_BYTES - 64);
    if (tid < 16) BST[tid] = 0u;
    __syncthreads();
    const XcdBarrier gbar = xcd_barrier_post((unsigned*)ws, BST);
    if (a.out == nullptr) grid.sync();
#define GRID_BARRIER() xcd_barrier(gbar)

    if (bx < 96) {
        LAS float* sil = (LAS float*)lds;
        LAS float* red = (LAS float*)(lds + 16384);
        const int kbase = 128 * wave;
#pragma unroll
        for (int bb = 0; bb < 4; ++bb)
#pragma unroll
            for (int j = 0; j < 2; ++j) sil[(wave * 4 + bb) * 128 + lane + 64 * j] = silu_f(a.c[bb * DM + kbase + lane + 64 * j]);
        asm volatile("s_waitcnt lgkmcnt(0)" ::: "memory");
        const int n = bx * 64 + lane;
        float ac0 = 0.f, ac1 = 0.f, ac2 = 0.f, ac3 = 0.f;
#pragma unroll 8
        for (int kk = 0; kk < 128; ++kk) { const float wv = a.w_ada[(size_t)(kbase + kk) * 6144 + n];
            ac0 += sil[(wave * 4 + 0) * 128 + kk] * wv; ac1 += sil[(wave * 4 + 1) * 128 + kk] * wv; ac2 += sil[(wave * 4 + 2) * 128 + kk] * wv; ac3 += sil[(wave * 4 + 3) * 128 + kk] * wv; }
        red[(wave * 4 + 0) * 64 + lane] = ac0; red[(wave * 4 + 1) * 64 + lane] = ac1; red[(wave * 4 + 2) * 64 + lane] = ac2; red[(wave * 4 + 3) * 64 + lane] = ac3;
        __syncthreads();
        if (wave < 4) { float s = a.b_ada[n];
#pragma unroll
            for (int w2 = 0; w2 < 8; ++w2) s += red[(w2 * 4 + wave) * 64 + lane];
            MOD[wave * 6144 + n] = s; }
        __syncthreads();
    }
    { float* RSSz = (float*)(ws + WS_RSS); for (int i = bx * NTHREADS + tid; i < 2 * M; i += G * NTHREADS) RSSz[i] = 0.f; }
    constexpr int I_IN = 16 * 160, I_OA = 8 * 32, I_OB = 8 * 32, I_OUT = 16 * 32, I_G = 16 * 88, I_U = 16 * 88, I_D = 44 * 32;
    constexpr int NITEMS = I_IN + I_OA + I_OB + I_OUT + I_G + I_U + I_D;
    {
        LAS float* scr = (LAS float*)(lds + wave * 16384);
        for (int it = gw; it < I_IN; it += NGW) {
            const int kb = it / 160, nb = it % 160, n0 = 32 * nb; const int dr = (n0 < 2560) ? n0 : (n0 < 3072 ? 4608 + (n0 - 2560) : n0 - 512);
            transpose_item(a.w_in, DM, DIN, WIN, 64 * kb, n0, dr, scr, lane);
        }
    }
    GRID_BARRIER();

    for (int m = gw; m < M; m += NGW) {
        const int bb = m / SEQ; const float* xr = a.x + (size_t)m * DM; const float* md = MOD + bb * 6144;
        f32x4 v[4]; float ss = 0.f;
#pragma unroll
        for (int j = 0; j < 4; ++j) { v[j] = *(const f32x4*)(xr + 4 * lane + 256 * j); ss += (v[j].x * v[j].x + v[j].y * v[j].y) + (v[j].z * v[j].z + v[j].w * v[j].w); }
        const float rstd = __builtin_amdgcn_rsqf(wave_sum(ss) * (1.f / DM) + EPS);
#pragma unroll
        for (int j = 0; j < 4; ++j) { const int k = 4 * lane + 256 * j;
            const f32x4 gm = *(const f32x4*)(a.g_mix + k), sc = *(const f32x4*)(md + 1024 + k), sh = *(const f32x4*)(md + k);
            const f32x4 hv = v[j] * rstd * gm * (sc + 1.f) + sh;
            u32x2 o; o.x = cvtpk(hv.x, hv.y); o.y = cvtpk(hv.z, hv.w); *(u32x2*)(XN + (size_t)m * DM + k) = o; }
    }
    GRID_BARRIER();

    {
        pg8::Gemm g{XN, WIN, M, NP, DM}; pg8::StaticOrder S; S.init(M, NP, G, bx);
        pg8::EpiStore<true> E{PROJ, PP, PC_Q / 256, PC_K / 256, PC_GA / 256, QSCALE, CTL + CW_NRM, GQ, PC_GA / 256};
        pg8::gemm_phase<pg8::EpiStore<true>, pg8::StaticOrder, true, true>(lds, g, S, E);
    }
    {
        pg8::Gemm g{WIN + (size_t)NP * DM, XN, 512, M, DM}; pg8::StaticOrder S; S.init(512, M, G, bx);
        pg8::EpiStore<false> E{VT, VTP, 0, 0, 0, 1.f, nullptr};
        pg8::gemm_phase<pg8::EpiStore<false>, pg8::StaticOrder, true, true>(lds, g, S, E);
    }
    GRID_BARRIER();

    {
        const float lambda_init = 0.8f - 0.6f * expf(-0.3f);
        const float d1 = wave_sum(a.lq1[lane] * a.lk1[lane]), d2 = wave_sum(a.lq2[lane] * a.lk2[lane]);
        const float lam = expf(d1) - expf(d2) + lambda_init;
        if (tid < 128) ((LAS float*)(lds + AT_G))[tid] = a.subln_g[tid];
        __syncthreads();
        const float nq = __uint_as_float(__hip_atomic_load(CTL + CW_NRM, __ATOMIC_RELAXED, __HIP_MEMORY_SCOPE_AGENT));
        const float nk = __uint_as_float(__hip_atomic_load(CTL + CW_NRM + 64, __ATOMIC_RELAXED, __HIP_MEMORY_SCOPE_AGENT));
        const float smax2 = 2.f * sqrtf(nq * nk) * 1.02f;
        LAS int* qslot = (LAS int*)(lds + AT_G + 1024);
        bool side_done = false;
        for (;;) {
            if (tid == 0) *qslot = (int)__hip_atomic_fetch_add(CTL + CW_QUEUE, 1u, __ATOMIC_RELAXED, __HIP_MEMORY_SCOPE_AGENT);
            __syncthreads();
            const int idx = __builtin_amdgcn_readfirstlane(*qslot);
            __syncthreads();
            if (idx < 1024) {
                int b, h, qb;
                if (idx < 512) { qb = 63 - (idx >> 3); b = (idx & 7) >> 1; h = 2 + (idx & 1); }
                else if (idx < 768) { const int r2 = idx - 512; qb = 63 - (r2 >> 2); b = r2 & 3; h = 1; }
                else { const int r2 = idx - 768; qb = 63 - (r2 >> 2); b = r2 & 3; h = 0; }
                const float slope2 = exp2f(-2.f * (float)(h + 1)) * LOG2E;
                attn_unit(lds, PROJ, VT, ATTNO, b, h, qb, lam, slope2, 1.f - lambda_init, (2.f * smax2 + 150.f) / slope2);
            }
            if (!side_done) {
                side_done = true;
                { LAS float* scr = (LAS float*)(lds + wave * 8704);
                  for (int it = I_IN + gw; it < NITEMS; it += NGW) {
                    int rI = it - I_IN;
                    if (rI < I_OA) { const int kb = rI / 32, nb = rI % 32; transpose_item(a.w_out_a, DC, DM, WOA, 64 * kb, 32 * nb, 32 * nb, scr, lane); continue; } rI -= I_OA;
                    if (rI < I_OB) { const int kb = rI / 32, nb = rI % 32; transpose_item(a.w_out_b, DA, DM, WOB, 64 * kb, 32 * nb, 32 * nb, scr, lane); continue; } rI -= I_OB;
                    if (rI < I_OUT) { const int kb = rI / 32, nb = rI % 32; transpose_item(a.w_out, DM, DM, WOUT, 64 * kb, 32 * nb, 32 * nb, scr, lane); continue; } rI -= I_OUT;
                    if (rI < I_G) { const int kb = rI / 88, nb = rI % 88, n0 = 32 * nb; transpose_item(a.w_gate, DM, FF, WGU, 64 * kb, n0, 256 * (n0 / 128) + (n0 % 128), scr, lane); continue; } rI -= I_G;
                    if (rI < I_U) { const int kb = rI / 88, nb = rI % 88, n0 = 32 * nb; transpose_item(a.w_up, DM, FF, WGU, 64 * kb, n0, 256 * (n0 / 128) + 128 + (n0 % 128), scr, lane); continue; } rI -= I_U;
                    { const int kb = rI / 32, nb = rI % 32; transpose_item(a.w_down, FF, DM, WD, 64 * kb, 32 * nb, 32 * nb, scr, lane); }
                  } }
    for (int item = bx * NTHREADS + tid; item < (M / 16) * 64; item += G * NTHREADS) {
        const int cgp = item & 63, strip = item >> 6, t0 = strip * 16, ch = cgp * 8;
        float w0[8], w1[8], w2[8], am1[8], am2[8];
#pragma unroll
        for (int j = 0; j < 8; ++j) { w0[j] = a.conv_w[ch + j]; w1[j] = a.conv_w[DC + ch + j]; w2[j] = a.conv_w[2 * DC + ch + j]; am1[j] = 0.f; am2[j] = 0.f; }
        if ((t0 % SEQ) != 0) {
            const bf16_t* p1 = PROJ + (size_t)(t0 - 1) * PP + ch; const bf16_t* p2 = PROJ + (size_t)(t0 - 2) * PP + ch;
            const u32x4 u1 = *(const u32x4*)(p1 + PC_U), c1 = *(const u32x4*)(p1 + PC_GC), u2 = *(const u32x4*)(p2 + PC_U), c2 = *(const u32x4*)(p2 + PC_GC);
#pragma unroll
            for (int j = 0; j < 4; ++j) { am1[2 * j] = bf_lo(u1[j]) * bf_lo(c1[j]); am1[2 * j + 1] = bf_hi(u1[j]) * bf_hi(c1[j]); am2[2 * j] = bf_lo(u2[j]) * bf_lo(c2[j]); am2[2 * j + 1] = bf_hi(u2[j]) * bf_hi(c2[j]); }
        }
#pragma unroll 4
        for (int tt = 0; tt < 16; ++tt) {
            const bf16_t* p = PROJ + (size_t)(t0 + tt) * PP + ch;
            const u32x4 uu = *(const u32x4*)(p + PC_U), gbv = *(const u32x4*)(p + PC_GB), gcv = *(const u32x4*)(p + PC_GC);
            float av[8], ov[8];
#pragma unroll
            for (int j = 0; j < 4; ++j) { av[2 * j] = bf_lo(uu[j]) * bf_lo(gcv[j]); av[2 * j + 1] = bf_hi(uu[j]) * bf_hi(gcv[j]); }
#pragma unroll
            for (int j = 0; j < 8; ++j) { const float z = w0[j] * am2[j] + w1[j] * am1[j] + w2[j] * av[j]; const float gbf = (j & 1) ? bf_hi(gbv[j >> 1]) : bf_lo(gbv[j >> 1]); ov[j] = gbf * z; am2[j] = am1[j]; am1[j] = av[j]; }
            u32x4 o; o.x = cvtpk(ov[0], ov[1]); o.y = cvtpk(ov[2], ov[3]); o.z = cvtpk(ov[4], ov[5]); o.w = cvtpk(ov[6], ov[7]);
            *(u32x4*)(CONVA + (size_t)(t0 + tt) * DC + ch) = o;
        }
    }
                __syncthreads();
            }
            if (idx >= 1024) break;
        }
    }
    GRID_BARRIER();

    {
        pg8::Gemm g{CONVA, WOA, M, DM, DC, ATTNO, WOB}; pg8::ChainOrder S; S.init(M, DM, G, bx);
        pg8::EpiMixChain E{GQ, XN};
        pg8::gemm_phase<pg8::EpiMixChain, pg8::ChainOrder, true, true>(lds, g, S, E);
    }
    GRID_BARRIER();

    _Float16* X1H = (_Float16*)(ws + WS_PROJ + 176 * MiB);
    bf16_t* H2 = (bf16_t*)(ws + WS_CONVA);
    float* RSS = (float*)(ws + WS_RSS);
    {
        pg8::Gemm g{XN, WOUT, M, DM, DM}; pg8::StaticOrder S; S.init(M, DM, G, bx);
        pg8::EpiResNorm<0> E{a.x, a.out, MOD + 2048, a.g_ffn, MOD + 4096, MOD + 3072, H2, RSS, CTL + CW_CNT1, X1H};
        pg8::gemm_phase<pg8::EpiResNorm<0>, pg8::StaticOrder, true, true>(lds, g, S, E);
    }
    GRID_BARRIER();

    {
        pg8::Gemm g{H2, WGU, M, NGU, DM}; pg8::StaticOrder S; S.init(M, NGU, G, bx);
        pg8::EpiSwiglu E{HFF};
        pg8::gemm_phase<pg8::EpiSwiglu, pg8::StaticOrder, true, true>(lds, g, S, E);
    }
    GRID_BARRIER();

    {
        pg8::Gemm g{HFF, WD, M, DM, FF}; pg8::StaticOrder S; S.init(M, DM, G, bx);
        pg8::EpiResNorm<1> E{nullptr, a.out, MOD + 5120, a.g_final, nullptr, nullptr, nullptr, RSS + M, CTL + CW_CNT2, X1H};
        pg8::gemm_phase<pg8::EpiResNorm<1>, pg8::StaticOrder, true, true>(lds, g, S, E);
    }
}

extern "C" void kernel_launch(void* const* d_in, const int* in_sizes, int n_in, void* d_out, int out_size, void* d_ws, size_t ws_size, hipStream_t stream) {
    static int grid = 0;
    if (grid == 0) {
        if (n_in != 20 || in_sizes[0] != M * DM || out_size != M * DM || ws_size < WS_END) {
            fprintf(stderr, "kernel_launch: unexpected shapes (n_in %d, in0 %d, out %d, ws %zu)\n", n_in, n_in > 0 ? in_sizes[0] : -1, out_size, ws_size); grid = -1; return; }
        int dev = 0, cus = 0, per_cu = 0;
        (void)hipGetDevice(&dev); (void)hipDeviceGetAttribute(&cus, hipDeviceAttributeMultiprocessorCount, dev);
        if (hipFuncSetAttribute((const void*)fwd_megakernel, hipFuncAttributeMaxDynamicSharedMemorySize, LDS_BYTES) != hipSuccess) { fprintf(stderr, "kernel_launch: hipFuncSetAttribute failed\n"); grid = -1; return; }
        if (hipOccupancyMaxActiveBlocksPerMultiprocessor(&per_cu, (const void*)fwd_megakernel, NTHREADS, LDS_BYTES) != hipSuccess || per_cu < 1) { fprintf(stderr, "kernel_launch: occupancy query failed (%d)\n", per_cu); per_cu = 1; }
        (void)hipGetLastError();
        grid = cus * per_cu;
    }
    if (grid < 0) return;
    Args a{};
    a.x = (const float*)d_in[0]; a.c = (const float*)d_in[1]; a.w_ada = (const float*)d_in[2]; a.b_ada = (const float*)d_in[3]; a.g_mix = (const float*)d_in[4];
    a.w_in = (const float*)d_in[5]; a.conv_w = (const float*)d_in[6]; a.w_out_a = (const float*)d_in[7]; a.lq1 = (const float*)d_in[8]; a.lk1 = (const float*)d_in[9];
    a.lq2 = (const float*)d_in[10]; a.lk2 = (const float*)d_in[11]; a.subln_g = (const float*)d_in[12]; a.w_out_b = (const float*)d_in[13]; a.w_out = (const float*)d_in[14];
    a.g_ffn = (const float*)d_in[15]; a.w_gate = (const float*)d_in[16]; a.w_up = (const float*)d_in[17]; a.w_down = (const float*)d_in[18]; a.g_final = (const float*)d_in[19];
    a.out = (float*)d_out; a.ws = (unsigned char*)d_ws;
    (void)hipMemsetAsync(d_ws, 0, 131072, stream);
    void* args[] = {&a};
    hipError_t e = hipLaunchCooperativeKernel((const void*)fwd_megakernel, dim3(grid), dim3(NTHREADS), args, LDS_BYTES, stream);
    if (e != hipSuccess) fprintf(stderr, "kernel_launch: cooperative launch failed: %s (grid %d)\n", hipGetErrorString(e), grid);
}
```

```cpp
#include <hip/hip_runtime.h>
#include <hip/hip_cooperative_groups.h>
#include <cstdio>
#include <cstdint>
namespace cg = cooperative_groups;

#define LAS __attribute__((address_space(3)))
typedef unsigned short bf16_t;
typedef short bf16x8 __attribute__((ext_vector_type(8)));
typedef float f32x4 __attribute__((ext_vector_type(4)));
typedef float f32x2 __attribute__((ext_vector_type(2)));
typedef float f32x16 __attribute__((ext_vector_type(16)));
typedef unsigned u32x4 __attribute__((ext_vector_type(4)));
typedef unsigned u32x2 __attribute__((ext_vector_type(2)));
typedef __bf16 bf16x2_t __attribute__((ext_vector_type(2)));
typedef _Float16 h16x4 __attribute__((ext_vector_type(4)));

constexpr int BATCH = 4, SEQ = 8192, DM = 1024, M = BATCH * SEQ;
constexpr int DIN = 5120, NP = 4608  , DC = 512, DA = 512, FF = 2816, NGU = 2 * FF;
constexpr int NHEAD = 4;
constexpr float EPS = 1e-6f;
constexpr float LOG2E = 1.4426950408889634f;
constexpr float QSCALE = 0.125f * LOG2E;
constexpr int PC_U = 0, PC_GB = 1024, PC_Q = 1536, PC_K = 2048, PC_GA = 2560, PC_GBT = 3584;
constexpr int PP = 2560;

constexpr size_t MiB = 1u << 20;
constexpr size_t WS_MOD = 1 * MiB;
constexpr size_t WS_WIN = 2 * MiB;
constexpr size_t WS_WOA = 12 * MiB;
constexpr size_t WS_WOB = 13 * MiB;
constexpr size_t WS_WOUT = 14 * MiB;
constexpr size_t WS_WGU = 16 * MiB;
constexpr size_t WS_WD = 27 * MiB;
constexpr size_t WS_RSS = 34 * MiB;
constexpr size_t WS_XN = 40 * MiB;
constexpr size_t WS_PROJ = 104 * MiB;
constexpr int VTP = M + 64;
constexpr size_t WS_VT = 392 * MiB;
constexpr size_t WS_CONVA = 425 * MiB;
constexpr size_t WS_ATTNO = 457 * MiB;
constexpr size_t WS_END = 489 * MiB;

constexpr int CW_QUEUE = 8192, CW_NRM = 8320, CW_CNT1 = 16384, CW_CNT2 = 20480;
constexpr int LDS_BYTES = 147456;
constexpr int NTHREADS = 512;

#define LOG2E_ 1.4426950408889634f
__device__ __forceinline__ unsigned cvtpk(float lo, float hi) { f32x2 v = {lo, hi}; bf16x2_t b = __builtin_convertvector(v, bf16x2_t); return __builtin_bit_cast(unsigned, b); }
__device__ __forceinline__ float bf_lo(unsigned w) { return __uint_as_float(w << 16); }
__device__ __forceinline__ float bf_hi(unsigned w) { return __uint_as_float(w & 0xffff0000u); }
__device__ __forceinline__ float sigmoid_f(float v) { return __builtin_amdgcn_rcpf(1.f + __builtin_amdgcn_exp2f(-LOG2E_ * v)); }
__device__ __forceinline__ float silu_f(float v) { return v * __builtin_amdgcn_rcpf(1.f + __builtin_amdgcn_exp2f(-LOG2E_ * v)); }
__device__ __forceinline__ float wave_sum(float v) {
#pragma unroll
    for (int o = 1; o < 64; o <<= 1) v += __shfl_xor(v, o);
    return v;
}

namespace pg8 {
constexpr int BM = 256, BK = 64, HALF = 128, HTB = HALF * BK * 2, STAGE_BYTES = 8 * HTB, NXCD = 8, WGM = 8;
__host__ __device__ __forceinline__ int lds_byte(int r, int c) { const int st = (r >> 4) * 2 + (c >> 5), rr = r & 15, cc = c & 31, ob = rr * 64 + cc * 2; return st * 1024 + (ob ^ (((ob >> 9) & 1) << 5)); }
__host__ __device__ __forceinline__ void stage_rc(int b, int& R, int& C) { const int st = b / 1024, sb = b % 1024, swz = sb ^ (((sb >> 9) & 1) << 5); R = (st >> 1) * 16 + swz / 64; C = (st & 1) * 32 + (swz % 64) / 2; }
__host__ __device__ __forceinline__ int perm32(int rho) { const int n = rho >> 4, i = rho & 15; return 8 * (i >> 2) + 4 * n + (i & 3); }

struct Unit { int pm, pn, kind; };
struct Gemm { const bf16_t* A; const bf16_t* Bt; int M, N, K; const bf16_t* A1 = nullptr; const bf16_t* Bt1 = nullptr; };

struct StaticOrder {
    int nM, nN, nwg, G, c;
    __host__ __device__ void init(int M_, int N_, int G_, int c_) { nM = M_ / BM; nN = N_ / BM; nwg = nM * nN; G = G_; c = c_; }
    __host__ __device__ bool next(int i, Unit& u) const {
        const long L = (long)i * G + c; if (L >= nwg) return false;
        int wgid = (int)L; { const int q = nwg / NXCD, r = nwg % NXCD, xcd = wgid % NXCD, off = wgid / NXCD; wgid = (xcd < r ? xcd * (q + 1) : r * (q + 1) + (xcd - r) * q) + off; }
        const int nig = WGM * nN, gid = wgid / nig, fm = gid * WGM, gsz = (nM - fm) < WGM ? (nM - fm) : WGM;
        u.pm = fm + ((wgid % nig) % gsz); u.pn = (wgid % nig) / gsz; u.kind = 0; return true;
    }
    __device__ __forceinline__ void a_ready(const Unit&) const {}
    __device__ __forceinline__ void done(const Unit&) const {}
};

struct ChainOrder {
    StaticOrder base;
    __host__ __device__ void init(int M_, int N_, int G_, int c_) { base.init(M_, N_, G_, c_); }
    __host__ __device__ bool next(int i, Unit& u) const { if (!base.next(i >> 1, u)) return false; u.kind = i & 1; return true; }
    __device__ __forceinline__ void a_ready(const Unit&) const {}
    __device__ __forceinline__ void done(const Unit&) const {}
};


template <bool TRACK> struct EpiStore {
    static constexpr bool PERM = true, AFTER_DRAIN = false, CHAIN = false;
    bf16_t* O; int ldc; int qt0, qt1, kt1; float qscale; unsigned* nrm;
    unsigned char* GQ = nullptr; int gt0 = 1 << 30; int ug1 = 0;
    __device__ __forceinline__ void operator()(const f32x4 (&acc)[2][2][4][2], const Unit& u, int wr, int wc, int fr, int fq) const {
        const int row0 = u.pm * BM + wr * 64 + fr, col0 = u.pn * BM + wc * 32 + 8 * fq;
        if (u.pn < ug1) {
            const int ac0 = u.pn * HALF + wc * 32 + 8 * fq;
#pragma unroll
            for (int ai = 0; ai < 2; ++ai)
#pragma unroll
                for (int m = 0; m < 4; ++m) { const f32x4 p0 = acc[ai][0][m][0] * acc[ai][1][m][0], p1 = acc[ai][0][m][1] * acc[ai][1][m][1];
                    u32x4 w; w.x = cvtpk(p0[0], p0[1]); w.y = cvtpk(p0[2], p0[3]); w.z = cvtpk(p1[0], p1[1]); w.w = cvtpk(p1[2], p1[3]);
                    *(u32x4*)(O + (size_t)(row0 + ai * HALF + m * 16) * ldc + ac0) = w; }
            return;
        }
        if (u.pn >= gt0) {
            const int gc0 = (u.pn - gt0) * BM + wc * 32 + 8 * fq;
#pragma unroll
            for (int ai = 0; ai < 2; ++ai)
#pragma unroll
                for (int m = 0; m < 4; ++m) { unsigned char* rowp = GQ + (size_t)(row0 + ai * HALF + m * 16) * 2048 + gc0;
#pragma unroll
                    for (int bj = 0; bj < 2; ++bj) { unsigned wlo = 0u, whi = 0u;
#pragma unroll
                        for (int j = 0; j < 4; ++j) {
                            const float s0 = sigmoid_f(acc[ai][bj][m][0][j]) * 255.f, s1 = sigmoid_f(acc[ai][bj][m][1][j]) * 255.f;
                            const unsigned q0 = (unsigned)__builtin_fmaxf(__builtin_rintf(s0), 1.f), q1 = (unsigned)__builtin_fmaxf(__builtin_rintf(s1), 1.f);
                            wlo |= q0 << (8 * j); whi |= q1 << (8 * j); }
                        *(u32x2*)(rowp + bj * HALF) = (u32x2){wlo, whi}; } }
            return;
        }
        const bool isq = (u.pn >= qt0 && u.pn < qt1), isk = (u.pn >= qt1 && u.pn < kt1);
        const float sc = isq ? qscale : 1.f;
        float rmax = 0.f;
#pragma unroll
        for (int ai = 0; ai < 2; ++ai)
#pragma unroll
            for (int m = 0; m < 4; ++m) { bf16_t* rowp = O + (size_t)(row0 + ai * HALF + m * 16) * ldc + col0;
#pragma unroll
                for (int bj = 0; bj < 2; ++bj) { const f32x4 v0 = acc[ai][bj][m][0] * sc, v1 = acc[ai][bj][m][1] * sc;
                    u32x4 w; w.x = cvtpk(v0[0], v0[1]); w.y = cvtpk(v0[2], v0[3]); w.z = cvtpk(v1[0], v1[1]); w.w = cvtpk(v1[2], v1[3]);
                    *(u32x4*)(rowp + bj * HALF) = w;
                    if (TRACK && (isq || isk)) { float q = (v0[0] * v0[0] + v0[1] * v0[1]) + (v0[2] * v0[2] + v0[3] * v0[3]) + (v1[0] * v1[0] + v1[1] * v1[1]) + (v1[2] * v1[2] + v1[3] * v1[3]);
                        q += __shfl_xor(q, 16); q += __shfl_xor(q, 32); rmax = __builtin_fmaxf(rmax, q); } } }
        if (TRACK && (isq || isk)) {
#pragma unroll
            for (int o = 1; o < 16; o <<= 1) rmax = __builtin_fmaxf(rmax, __shfl_xor(rmax, o));
            if (fr == 0 && fq == 0) (void)__hip_atomic_fetch_max(nrm + (isk ? 64 : 0), __float_as_uint(rmax), __ATOMIC_RELAXED, __HIP_MEMORY_SCOPE_AGENT);
        }
    }
};
struct EpiMixChain {
    static constexpr bool PERM = true, AFTER_DRAIN = false, CHAIN = true;
    const unsigned char* GQ; bf16_t* T;
    __device__ __forceinline__ void operator()(f32x4 (&acc)[2][2][4][2], const Unit& u, int wr, int wc, int fr, int fq) const {
        const int row0 = u.pm * BM + wr * 64 + fr, col0 = u.pn * BM + wc * 32 + 8 * fq;
        if (u.kind == 0) {
#pragma unroll
            for (int ai = 0; ai < 2; ++ai)
#pragma unroll
                for (int m = 0; m < 4; ++m) { const unsigned char* gp = GQ + (size_t)(row0 + ai * HALF + m * 16) * 2048 + col0;
#pragma unroll
                    for (int bj = 0; bj < 2; ++bj) {
                        const u32x2 qa = *(const u32x2*)(gp + bj * HALF), qb = *(const u32x2*)(gp + 1024 + bj * HALF);
#pragma unroll
                        for (int j = 0; j < 4; ++j) {
                            const float r0 = (float)((qa.x >> (8 * j)) & 0xffu) * __builtin_amdgcn_rcpf((float)((qb.x >> (8 * j)) & 0xffu));
                            const float r1 = (float)((qa.y >> (8 * j)) & 0xffu) * __builtin_amdgcn_rcpf((float)((qb.y >> (8 * j)) & 0xffu));
                            acc[ai][bj][m][0][j] *= r0; acc[ai][bj][m][1][j] *= r1; } }
                    if (m == 3) asm volatile("" ::: "memory"); }
        } else {
#pragma unroll
            for (int ai = 0; ai < 2; ++ai)
#pragma unroll
                for (int m = 0; m < 4; ++m) { const size_t row = (size_t)(row0 + ai * HALF + m * 16);
#pragma unroll
                    for (int bj = 0; bj < 2; ++bj) {
                        const u32x2 qb = *(const u32x2*)(GQ + row * 2048 + 1024 + col0 + bj * HALF);
                        const f32x4 a0 = acc[ai][bj][m][0], a1 = acc[ai][bj][m][1];
                        float f0[4], f1[4];
#pragma unroll
                        for (int j = 0; j < 4; ++j) { f0[j] = (float)((qb.x >> (8 * j)) & 0xffu) * (1.f / 255.f) * a0[j]; f1[j] = (float)((qb.y >> (8 * j)) & 0xffu) * (1.f / 255.f) * a1[j]; }
                        u32x4 w; w.x = cvtpk(f0[0], f0[1]); w.y = cvtpk(f0[2], f0[3]); w.z = cvtpk(f1[0], f1[1]); w.w = cvtpk(f1[2], f1[3]);
                        *(u32x4*)(T + row * DM + col0 + bj * HALF) = w; }
                    if (m == 3) asm volatile("" ::: "memory"); }
        }
    }
};
struct EpiRes {
    static constexpr bool PERM = false, AFTER_DRAIN = false, CHAIN = false;
    const float* base; float* out; const float* gate;
    __device__ __forceinline__ void operator()(const f32x4 (&acc)[2][2][4][2], const Unit& u, int wr, int wc, int fr, int fq) const {
        const int col0 = u.pn * BM + wc * 32 + 4 * fq; const int b = (u.pm * BM) / SEQ;
        f32x4 gv[2][2];
#pragma unroll
        for (int bj = 0; bj < 2; ++bj)
#pragma unroll
            for (int n = 0; n < 2; ++n) gv[bj][n] = *(const f32x4*)(gate + (size_t)b * 6144 + col0 + bj * HALF + n * 16);
#pragma unroll
        for (int ai = 0; ai < 2; ++ai)
#pragma unroll
            for (int m = 0; m < 4; ++m) { const size_t off = (size_t)(u.pm * BM + ai * HALF + wr * 64 + m * 16 + fr) * DM + col0;
#pragma unroll
                for (int bj = 0; bj < 2; ++bj)
#pragma unroll
                    for (int n = 0; n < 2; ++n) { const f32x4 bs = *(const f32x4*)(base + off + bj * HALF + n * 16);
                        *(f32x4*)(out + off + bj * HALF + n * 16) = bs + gv[bj][n] * acc[ai][bj][m][n]; } }
    }
};
template <int MODE> struct EpiResNorm {
    static constexpr bool PERM = false, AFTER_DRAIN = false, CHAIN = false;
    const float* base; float* out; const float* gate; const float* gn; const float* sc; const float* sh; bf16_t* H2; float* rss; unsigned* cnt; _Float16* x1h;
    __device__ __forceinline__ void operator()(f32x4 (&acc)[2][2][4][2], const Unit& u, int wr, int wc, int fr, int fq) const {
        const int col0 = u.pn * BM + wc * 32 + 4 * fq; const int b = (u.pm * BM) / SEQ;
        const int rowb = u.pm * BM + wr * 64 + fr;
        {
            f32x4 gv[2][2];
#pragma unroll
            for (int bj = 0; bj < 2; ++bj)
#pragma unroll
                for (int n = 0; n < 2; ++n) gv[bj][n] = *(const f32x4*)(gate + (size_t)b * 6144 + col0 + bj * HALF + n * 16);
#pragma unroll
            for (int ai = 0; ai < 2; ++ai)
#pragma unroll
                for (int m = 0; m < 4; ++m) { const int row = rowb + ai * HALF + m * 16; const size_t off = (size_t)row * DM + col0; float s = 0.f;
#pragma unroll
                    for (int bj = 0; bj < 2; ++bj)
#pragma unroll
                        for (int n = 0; n < 2; ++n) { f32x4 bs; if (MODE == 0) bs = *(const f32x4*)(base + off + bj * HALF + n * 16); else bs = __builtin_convertvector(*(const h16x4*)(x1h + off + bj * HALF + n * 16), f32x4);
                            const f32x4 v = bs + gv[bj][n] * acc[ai][bj][m][n];
                            acc[ai][bj][m][n] = v; if (MODE == 0) *(h16x4*)(x1h + off + bj * HALF + n * 16) = __builtin_convertvector(v, h16x4);
                            s += (v[0] * v[0] + v[1] * v[1]) + (v[2] * v[2] + v[3] * v[3]); }
                    s += __shfl_xor(s, 16); s += __shfl_xor(s, 32);
                    if (fq == 0) (void)__hip_atomic_fetch_add(rss + row, s, __ATOMIC_RELAXED, __HIP_MEMORY_SCOPE_AGENT); }
        }
        asm volatile("s_waitcnt vmcnt(0)" ::: "memory");
        if (fr == 0 && fq == 0) {
            unsigned* cp = cnt + 16 * u.pm;
            (void)__hip_atomic_fetch_add(cp, 1u, __ATOMIC_RELAXED, __HIP_MEMORY_SCOPE_AGENT);
            unsigned sp = 0;
            while (__hip_atomic_load(cp, __ATOMIC_RELAXED, __HIP_MEMORY_SCOPE_AGENT) < 32u) { __builtin_amdgcn_s_sleep(2); if (++sp > (1u << 22)) break; }
        }
        asm volatile("" ::: "memory");
        f32x4 gf[2][2], scv[2][2], shv[2][2];
#pragma unroll
        for (int bj = 0; bj < 2; ++bj)
#pragma unroll
            for (int n = 0; n < 2; ++n) { gf[bj][n] = *(const f32x4*)(gn + col0 + bj * HALF + n * 16);
                if (MODE == 0) { scv[bj][n] = *(const f32x4*)(sc + (size_t)b * 6144 + col0 + bj * HALF + n * 16); shv[bj][n] = *(const f32x4*)(sh + (size_t)b * 6144 + col0 + bj * HALF + n * 16);
                    gf[bj][n] = gf[bj][n] * (scv[bj][n] + 1.f); } }
#pragma unroll
        for (int ai = 0; ai < 2; ++ai)
#pragma unroll
            for (int m = 0; m < 4; ++m) { const int row = rowb + ai * HALF + m * 16; const size_t off = (size_t)row * DM + col0;
                const float rs = __hip_atomic_load(rss + row, __ATOMIC_RELAXED, __HIP_MEMORY_SCOPE_AGENT);
                const float rstd = __builtin_amdgcn_rsqf(rs * (1.f / DM) + EPS);
#pragma unroll
                for (int bj = 0; bj < 2; ++bj)
#pragma unroll
                    for (int n = 0; n < 2; ++n) {
                        if (MODE == 0) { const f32x4 hv = acc[ai][bj][m][n] * rstd * gf[bj][n] + shv[bj][n];
                            u32x2 o; o.x = cvtpk(hv[0], hv[1]); o.y = cvtpk(hv[2], hv[3]); *(u32x2*)(H2 + off + bj * HALF + n * 16) = o; }
                        else *(f32x4*)(out + off + bj * HALF + n * 16) = acc[ai][bj][m][n] * rstd * gf[bj][n]; } }
    }
};
struct EpiSwiglu {
    static constexpr bool PERM = true, AFTER_DRAIN = false, CHAIN = false;
    bf16_t* H;
    __device__ __forceinline__ void operator()(const f32x4 (&acc)[2][2][4][2], const Unit& u, int wr, int wc, int fr, int fq) const {
        const int row0 = u.pm * BM + wr * 64 + fr, col0 = u.pn * HALF + wc * 32 + 8 * fq;
#pragma unroll
        for (int ai = 0; ai < 2; ++ai)
#pragma unroll
            for (int m = 0; m < 4; ++m) { bf16_t* rowp = H + (size_t)(row0 + ai * HALF + m * 16) * FF + col0;
                const f32x4 g0 = acc[ai][0][m][0], g1 = acc[ai][0][m][1], u0 = acc[ai][1][m][0], u1 = acc[ai][1][m][1];
                u32x4 w; w.x = cvtpk(silu_f(g0[0]) * u0[0], silu_f(g0[1]) * u0[1]); w.y = cvtpk(silu_f(g0[2]) * u0[2], silu_f(g0[3]) * u0[3]);
                w.z = cvtpk(silu_f(g1[0]) * u1[0], silu_f(g1[1]) * u1[1]); w.w = cvtpk(silu_f(g1[2]) * u1[2], silu_f(g1[3]) * u1[3]);
                *(u32x4*)rowp = w; }
    }
};

template <class Epi, class Sched, bool ALIGN_EPI = false, bool SP2 = false>
__device__ __forceinline__ void gemm_phase(LAS unsigned char* lds, const Gemm g, const Sched& S, const Epi& E) {
    int tid = threadIdx.x; asm volatile("" : "+v"(tid));
    const int wid = __builtin_amdgcn_readfirstlane(tid >> 6), lane = tid & 63, wr = wid >> 2, wc = wid & 3, fr = lane & 15, fq = lane >> 4;
    const int K = g.K, nt = K / BK;
    unsigned voffA[2], voffB[2];
#pragma unroll
    for (int i = 0; i < 2; ++i) { int R, C; stage_rc(tid * 16 + i * 8192, R, C); const int Rb = Epi::PERM ? ((R & ~31) + perm32(R & 31)) : R;
        voffA[i] = (unsigned)(R * K + C) * 2u; voffB[i] = (unsigned)(Rb * K + C) * 2u; }
    const size_t kstep = (size_t)(BK * 2);
    const size_t hstep = (size_t)HALF * K * 2;
    const size_t tstep = 2 * hstep;
    const unsigned ldsw = (unsigned)wid * 1024u;
    const int aoff = lds_byte(wr * 64 + fr, fq * 8), boff = lds_byte(wc * 32 + fr, fq * 8);
#define PG8_SA(b, h) (((b) * 2 + (h)) * HTB)
#define PG8_SB(b, h) ((4 + (b) * 2 + (h)) * HTB)
#define PG8_STAGE(bufoff, gbase, voff) do { _Pragma("unroll") for (int _i = 0; _i < 2; ++_i) \
        __builtin_amdgcn_global_load_lds((const unsigned*)((const char*)(gbase) + (voff)[_i]), (LAS unsigned*)(lds + (bufoff) + ldsw + _i * 8192), 16, 0, 0); } while (0)
#define PG8_LDA(dst, b, h) do { _Pragma("unroll") for (int m = 0; m < 4; ++m) _Pragma("unroll") for (int k = 0; k < 2; ++k) dst[m][k] = *(const LAS bf16x8*)(lds + PG8_SA(b, h) + aoff + m * 2048 + k * 1024); } while (0)
#define PG8_LDB(dst, b, h) do { _Pragma("unroll") for (int n = 0; n < 2; ++n) _Pragma("unroll") for (int k = 0; k < 2; ++k) dst[n][k] = *(const LAS bf16x8*)(lds + PG8_SB(b, h) + boff + n * 2048 + k * 1024); } while (0)
#define PG8_MMA(ai, bj, At, Bt) do { __builtin_amdgcn_s_setprio(1); _Pragma("unroll") for (int m = 0; m < 4; ++m) _Pragma("unroll") for (int n = 0; n < 2; ++n) _Pragma("unroll") for (int k = 0; k < 2; ++k) \
        acc[ai][bj][m][n] = __builtin_amdgcn_mfma_f32_16x16x32_bf16(Bt[n][k], At[m][k], acc[ai][bj][m][n], 0, 0, 0); __builtin_amdgcn_s_setprio(0); } while (0)
#define PG8_WAIT_V(n) asm volatile("s_waitcnt vmcnt(" #n ")" ::: "memory")
#define PG8_WAIT_L(n) asm volatile("s_waitcnt lgkmcnt(" #n ")" ::: "memory")
#define PG8_BAR __builtin_amdgcn_s_barrier()
#define PG8_SCHED __builtin_amdgcn_sched_barrier(0)
    Unit cur, nxt; int ui = 0;
    if (!S.next(0, cur)) return;
    f32x4 acc[2][2][4][2];
#pragma unroll
    for (int a = 0; a < 2; ++a)
#pragma unroll
        for (int b = 0; b < 2; ++b)
#pragma unroll
            for (int m = 0; m < 4; ++m)
#pragma unroll
                for (int n = 0; n < 2; ++n) acc[a][b][m][n] = (f32x4){0.f, 0.f, 0.f, 0.f};
    bf16x8 At[4][2], B0[2][2], B1[2][2];
    const char* cA = (const char*)(cur.kind ? g.A1 : g.A) + (size_t)cur.pm * tstep; const char* cB = (const char*)(cur.kind ? g.Bt1 : g.Bt) + (size_t)cur.pn * tstep;
    S.a_ready(cur);
    if constexpr (SP2) {
        PG8_STAGE(PG8_SB(0, 0), cB, voffB); PG8_STAGE(PG8_SB(0, 1), cB + hstep, voffB); PG8_STAGE(PG8_SA(0, 0), cA, voffA); PG8_STAGE(PG8_SA(0, 1), cA + hstep, voffA);
        if (wr == 1) PG8_BAR;
        PG8_WAIT_V(2); PG8_BAR;
        PG8_STAGE(PG8_SB(1, 0), cB + kstep, voffB); PG8_STAGE(PG8_SA(1, 0), cA + kstep, voffA); PG8_STAGE(PG8_SB(1, 1), cB + hstep + kstep, voffB);
        PG8_WAIT_V(6); PG8_BAR;
    } else {
        PG8_STAGE(PG8_SB(0, 0), cB, voffB); PG8_STAGE(PG8_SA(0, 0), cA, voffA); PG8_STAGE(PG8_SB(0, 1), cB + hstep, voffB); PG8_STAGE(PG8_SA(0, 1), cA + hstep, voffA);
        if (wr == 1) PG8_BAR;
        PG8_WAIT_V(4); PG8_BAR;
        PG8_STAGE(PG8_SB(1, 0), cB + kstep, voffB); PG8_STAGE(PG8_SA(1, 0), cA + kstep, voffA); PG8_STAGE(PG8_SB(1, 1), cB + hstep + kstep, voffB);
        PG8_WAIT_V(6); PG8_BAR;
    }
    for (;;) {
        const bool has_next = S.next(ui + 1, nxt);
        const char* nA = has_next ? (const char*)(nxt.kind ? g.A1 : g.A) + (size_t)nxt.pm * tstep : cA; const char* nB = has_next ? (const char*)(nxt.kind ? g.Bt1 : g.Bt) + (size_t)nxt.pn * tstep : cB;
        for (int t = 0; t < nt; t += 2) {
            const bool last = (t == nt - 2);
            const char* a1 = cA + (size_t)(t + 1) * kstep;
            const char* a2 = last ? nA : cA + (size_t)(t + 2) * kstep; const char* b2 = last ? nB : cB + (size_t)(t + 2) * kstep;
            const char* a3 = a2 + kstep; const char* b3 = b2 + kstep;
            if (last && has_next) S.a_ready(nxt);
            if constexpr (SP2) {
            PG8_LDB(B0, 0, 0); PG8_LDB(B1, 0, 1); PG8_SCHED; PG8_LDA(At, 0, 0); PG8_STAGE(PG8_SA(1, 1), a1 + hstep, voffA);
            PG8_WAIT_V(8); PG8_WAIT_L(0); PG8_BAR; PG8_MMA(0, 0, At, B0); PG8_MMA(0, 1, At, B1); PG8_BAR; PG8_SCHED;
            PG8_LDA(At, 0, 1); PG8_STAGE(PG8_SB(0, 0), b2, voffB); PG8_STAGE(PG8_SB(0, 1), b2 + hstep, voffB); PG8_STAGE(PG8_SA(0, 0), a2, voffA);
            PG8_WAIT_V(8); PG8_WAIT_L(0); PG8_BAR; PG8_MMA(1, 0, At, B0); PG8_MMA(1, 1, At, B1); PG8_BAR; PG8_SCHED;
            PG8_LDB(B0, 1, 0); PG8_LDB(B1, 1, 1); PG8_SCHED; PG8_LDA(At, 1, 0); PG8_STAGE(PG8_SA(0, 1), a2 + hstep, voffA);
            PG8_WAIT_V(8); PG8_WAIT_L(0); PG8_BAR; PG8_MMA(0, 0, At, B0); PG8_MMA(0, 1, At, B1); PG8_BAR; PG8_SCHED;
            PG8_LDA(At, 1, 1); PG8_STAGE(PG8_SB(1, 0), b3, voffB); PG8_STAGE(PG8_SB(1, 1), b3 + hstep, voffB); PG8_STAGE(PG8_SA(1, 0), a3, voffA);
            PG8_WAIT_V(8); PG8_WAIT_L(0); PG8_BAR; PG8_MMA(1, 0, At, B0); PG8_MMA(1, 1, At, B1); PG8_BAR; PG8_SCHED;
            } else {
            PG8_LDB(B0, 0, 0); PG8_SCHED; PG8_LDA(At, 0, 0); PG8_STAGE(PG8_SA(1, 1), a1 + hstep, voffA);
            PG8_WAIT_L(8); PG8_BAR; PG8_WAIT_L(0); PG8_MMA(0, 0, At, B0); PG8_BAR; PG8_SCHED;
            PG8_LDB(B1, 0, 1); PG8_STAGE(PG8_SB(0, 0), b2, voffB);
            PG8_BAR; PG8_WAIT_L(0); PG8_MMA(0, 1, At, B1); PG8_BAR;
            PG8_LDA(At, 0, 1); PG8_STAGE(PG8_SA(0, 0), a2, voffA);
            PG8_BAR; PG8_WAIT_L(0); PG8_MMA(1, 0, At, B0); PG8_BAR; PG8_SCHED;
            PG8_STAGE(PG8_SB(0, 1), b2 + hstep, voffB);
            PG8_WAIT_V(6); PG8_BAR; PG8_MMA(1, 1, At, B1); PG8_BAR;
            PG8_LDB(B0, 1, 0); PG8_SCHED; PG8_LDA(At, 1, 0); PG8_STAGE(PG8_SA(0, 1), a2 + hstep, voffA);
            PG8_WAIT_L(8); PG8_BAR; PG8_WAIT_L(0); PG8_MMA(0, 0, At, B0); PG8_BAR; PG8_SCHED;
            PG8_LDB(B1, 1, 1); PG8_STAGE(PG8_SB(1, 0), b3, voffB);
            PG8_BAR; PG8_WAIT_L(0); PG8_MMA(0, 1, At, B1); PG8_BAR;
            PG8_LDA(At, 1, 1); PG8_STAGE(PG8_SA(1, 0), a3, voffA);
            PG8_BAR; PG8_WAIT_L(0); PG8_MMA(1, 0, At, B0); PG8_BAR; PG8_SCHED;
            PG8_STAGE(PG8_SB(1, 1), b3 + hstep, voffB);
            PG8_WAIT_V(6); PG8_BAR; PG8_MMA(1, 1, At, B1); PG8_BAR;
            }
        }
        if constexpr (ALIGN_EPI) { if (wr == 0) PG8_BAR; }
        if constexpr (!Epi::AFTER_DRAIN) { E(acc, cur, wr, wc, fr, fq); S.done(cur); }
        if (!has_next) break;
        if constexpr (Epi::CHAIN) {
            const float keep = (cur.kind == 0) ? 1.f : 0.f;
#pragma unroll
            for (int a = 0; a < 2; ++a)
#pragma unroll
                for (int b = 0; b < 2; ++b)
#pragma unroll
                    for (int m = 0; m < 4; ++m)
#pragma unroll
                        for (int n = 0; n < 2; ++n) acc[a][b][m][n] *= keep;
        } else {
#pragma unroll
        for (int a = 0; a < 2; ++a)
#pragma unroll
            for (int b = 0; b < 2; ++b)
#pragma unroll
                for (int m = 0; m < 4; ++m)
#pragma unroll
                    for (int n = 0; n < 2; ++n) acc[a][b][m][n] = (f32x4){0.f, 0.f, 0.f, 0.f};
        }
        cur = nxt; cA = nA; cB = nB; ++ui;
        if constexpr (ALIGN_EPI) { if (wr == 1) PG8_BAR; }
    }
    PG8_WAIT_V(0);
    if constexpr (!ALIGN_EPI) { if (wr == 0) PG8_BAR; }
    PG8_BAR;
#undef PG8_SA
#undef PG8_SB
#undef PG8_STAGE
#undef PG8_LDA
#undef PG8_LDB
#undef PG8_MMA
#undef PG8_WAIT_V
#undef PG8_WAIT_L
#undef PG8_BAR
#undef PG8_SCHED
}
}


#define XB_TMO      128
#define XB_XCNT(j)  (256  + 64 * (j))
#define XB_XSUB(j)  (1280 + 64 * (j))
#define XB_XGEN(j)  (2304 + 64 * (j))
#define XB_TOP      3328
#define XB_TOPGEN   3392
#define XCD_BAR_WORDS 3456
#define XB_SPIN_CAP (1u << 20)
__device__ __forceinline__ unsigned xb_ld(unsigned* p)              { return __hip_atomic_load(p, __ATOMIC_RELAXED, __HIP_MEMORY_SCOPE_AGENT); }
__device__ __forceinline__ unsigned xb_add(unsigned* p, unsigned v) { return __hip_atomic_fetch_add(p, v, __ATOMIC_RELAXED, __HIP_MEMORY_SCOPE_AGENT); }
__device__ __forceinline__ unsigned xb_xcc_id() { return (unsigned)__builtin_amdgcn_s_getreg((3 << 11) | 20) & 0xFu; }
#define XB_SPIN(cond, bar) do { unsigned _sp = 0; while (cond) { __builtin_amdgcn_s_sleep(1); \
    if ((++_sp & 255u) == 0u) { if (xb_ld(&(bar)[XB_TMO])) break; if (_sp > XB_SPIN_CAP) { atomicAdd(&(bar)[XB_TMO], 1u); break; } } } } while (0)
struct XcdBarrier { unsigned* bar; unsigned x; volatile LAS unsigned* st; };
__device__ __forceinline__ XcdBarrier xcd_barrier_post(unsigned* bar, volatile LAS unsigned* st) {
    XcdBarrier b; b.bar = bar; b.x = xb_xcc_id(); b.st = st;
    if (threadIdx.x == 0) (void)xb_add(&bar[XB_XCNT(b.x)], 1u);
    return b;
}
__device__ __forceinline__ void xcd_barrier_complete(unsigned* bar, unsigned x, unsigned& nloc, unsigned& nx) {
    const unsigned G = gridDim.x * gridDim.y * gridDim.z;
    unsigned sum, cnt, mine, sp = 0u;
    for (;;) {
        sum = 0u; cnt = 0u; mine = 0u;
#pragma unroll
        for (unsigned j = 0; j < 16; ++j) { const unsigned c = xb_ld(&bar[XB_XCNT(j)]); sum += c; cnt += (c > 0u) ? 1u : 0u; mine = (j == x) ? c : mine; }
        if (sum == G) break;
        __builtin_amdgcn_s_sleep(1);
        if ((++sp & 255u) == 0u) { if (xb_ld(&bar[XB_TMO])) break; if (sp > XB_SPIN_CAP) { atomicAdd(&bar[XB_TMO], 1u); break; } }
    }
    nloc = mine > 0u ? mine : 1u; nx = cnt > 0u ? cnt : 1u;
}
__device__ __forceinline__ void xcd_barrier(const XcdBarrier& b) {
    asm volatile("s_waitcnt vmcnt(0)" ::: "memory");
    __syncthreads();
    if (threadIdx.x == 0) {
        unsigned* bar = b.bar;
        __builtin_amdgcn_s_waitcnt(0);
        unsigned nloc = b.st[0], nx = b.st[1];
        if (nloc == 0u) { xcd_barrier_complete(bar, b.x, nloc, nx); b.st[0] = nloc; b.st[1] = nx; }
        const unsigned old = xb_add(&bar[XB_XSUB(b.x)], 1u);
        const unsigned gen = old / nloc;
        if (old + 1u == (gen + 1u) * nloc) {
            __builtin_amdgcn_fence(__ATOMIC_RELEASE, "agent");
            asm volatile("s_waitcnt vmcnt(0)" ::: "memory");
            const unsigned og = xb_add(&bar[XB_TOP], 1u);
            const unsigned tg = og / nx;
            if (og + 1u == (tg + 1u) * nx) xb_add(&bar[XB_TOPGEN], 1u);
            else XB_SPIN(xb_ld(&bar[XB_TOPGEN]) == tg, bar);
            __builtin_amdgcn_fence(__ATOMIC_ACQUIRE, "agent");
            xb_add(&bar[XB_XGEN(b.x)], 1u);
            asm volatile("s_waitcnt vmcnt(0)" ::: "memory");
        } else {
            XB_SPIN(xb_ld(&bar[XB_XGEN(b.x)]) == gen, bar);
            __builtin_amdgcn_fence(__ATOMIC_ACQUIRE, "agent");
            asm volatile("s_waitcnt vmcnt(0)" ::: "memory");
        }
    }
    __syncthreads();
}

struct Args {
    const float* x; const float* c; const float* w_ada; const float* b_ada; const float* g_mix; const float* w_in; const float* conv_w; const float* w_out_a;
    const float* lq1; const float* lk1; const float* lq2; const float* lk2; const float* subln_g; const float* w_out_b; const float* w_out; const float* g_ffn;
    const float* w_gate; const float* w_up; const float* w_down; const float* g_final;
    float* out; unsigned char* ws;
};

__device__ __forceinline__ void transpose_item(const float* W, int K, int N, bf16_t* WT, int k0, int n0, int drow0, LAS float* scr, int lane) {
#pragma unroll 8
    for (int i = 0; i < 32; ++i) { const int kk = 2 * i + (lane >> 5); scr[kk * 33 + (lane & 31)] = W[(size_t)(k0 + kk) * N + n0 + (lane & 31)]; }
    asm volatile("s_waitcnt lgkmcnt(0)" ::: "memory");
    const int c = lane & 7;
#pragma unroll
    for (int j = 0; j < 4; ++j) { const int n = (lane >> 3) + 8 * j; const LAS float* s = scr + (8 * c) * 33 + n;
        u32x4 o; o.x = cvtpk(s[0 * 33], s[1 * 33]); o.y = cvtpk(s[2 * 33], s[3 * 33]); o.z = cvtpk(s[4 * 33], s[5 * 33]); o.w = cvtpk(s[6 * 33], s[7 * 33]);
        *(u32x4*)(WT + (size_t)(drow0 + n) * K + k0 + 8 * c) = o; }
    asm volatile("s_waitcnt lgkmcnt(0)" ::: "memory");
}

constexpr int AT_KROW = 272, AT_VROW = 144;
constexpr int AT_KBUF = 64 * AT_KROW, AT_VBUF = 128 * AT_VROW;
constexpr int AT_V0 = 2 * AT_KBUF, AT_G = 73728;
#define MFMA32(a, b, c) __builtin_amdgcn_mfma_f32_32x32x16_bf16((a), (b), (c), 0, 0, 0)
__device__ __forceinline__ void qk_half(f32x16& s, const LAS unsigned char* kq_, const bf16x8 (&qf)[4]) {
    s = f32x16{};
#pragma unroll
    for (int ks = 0; ks < 4; ++ks) { const bf16x8 a = *(const LAS bf16x8*)(kq_ + ks * 32); s = MFMA32(a, qf[ks], s); }
}
__device__ __forceinline__ void pv_half(f32x16 (&o)[4], const LAS unsigned char* vc_, const bf16x8 (&pf)[2]) {
#pragma unroll
    for (int bl = 0; bl < 4; ++bl)
#pragma unroll
        for (int s2 = 0; s2 < 2; ++s2) { const bf16x8 a = *(const LAS bf16x8*)(vc_ + bl * 32 * AT_VROW + s2 * 32); o[bl] = MFMA32(a, pf[s2], o[bl]); }
}
template <bool DIAG, int KB> __device__ __forceinline__ void sm_half(f32x16& s, bf16x8 (&pf)[2], float& mref, float& lrun, float& alpha, float slope2, float dq) {
    float mx = -1e30f;
#pragma unroll
    for (int i = 0; i < 16; ++i) { const float ci = (float)(16 * (i >> 3) + (i & 7) + 32 * KB);
        if (DIAG) s[i] = __builtin_fmaf(-slope2, __builtin_fabsf(dq - ci), s[i]);
        else if (ci != 0.f) s[i] = __builtin_fmaf(slope2, ci, s[i]);
        mx = __builtin_fmaxf(mx, s[i]); }
    const float A = DIAG ? 0.f : -slope2 * dq;
    { const auto rr = __builtin_amdgcn_permlane32_swap(__float_as_uint(mx), __float_as_uint(mx), false, false);
      mx = __builtin_fmaxf(__uint_as_float(rr[0]), __uint_as_float(rr[1])) + A; }
    const float mnew = (mx > mref + 6.f) ? mx : mref;
    alpha = __builtin_amdgcn_exp2f(mref - mnew);
    mref = mnew;
    const float off = A - mnew;
    float ps = 0.f;
#pragma unroll
    for (int i = 0; i < 16; ++i) { s[i] = __builtin_amdgcn_exp2f(s[i] + off); ps += s[i]; }
    lrun = lrun * alpha + ps;
    u32x4 p;
    p.x = cvtpk(s[0], s[1]); p.y = cvtpk(s[2], s[3]); p.z = cvtpk(s[4], s[5]); p.w = cvtpk(s[6], s[7]); pf[0] = __builtin_bit_cast(bf16x8, p);
    p.x = cvtpk(s[8], s[9]); p.y = cvtpk(s[10], s[11]); p.z = cvtpk(s[12], s[13]); p.w = cvtpk(s[14], s[15]); pf[1] = __builtin_bit_cast(bf16x8, p);
}
__device__ __forceinline__ const LAS unsigned char* hf_addr(int g, const LAS unsigned char* kq_, const LAS unsigned char* vc_) {
    return g < 4 ? kq_ + g * 32 : vc_ + ((g - 4) >> 1) * 32 * AT_VROW + ((g - 4) & 1) * 32;
}
__device__ __forceinline__ float fma_negabs(float nslope, float d, float s) { float r; asm("v_fma_f32 %0, %1, |%2|, %3" : "=v"(r) : "v"(nslope), "v"(d), "v"(s)); return r; }
template <int KB, bool NEXT> __device__ __forceinline__ void fused_half(f32x16& SQ, f32x16& SS, bf16x8 (&PS)[2], const bf16x8 (&PP)[2], f32x16 (&o)[4], const bf16x8 (&qf)[4], f32x16& negm,
                                                          const LAS unsigned char* kq_, const LAS unsigned char* vc_, float& mref, float& lrun, float& alpha, float nslope2, float dqm,
                                                          bf16x8& f0, bf16x8& f1, const LAS unsigned char* nkq_) {
    float mx = -3.0e38f, ps = 0.f;
    alpha = 1.f;
    bf16x8 fr[3];
    fr[0] = f0; fr[1] = f1;
    __builtin_amdgcn_sched_barrier(0);
#pragma unroll
    for (int g = 0; g < 12; ++g) {
        if (g + 2 < 12) fr[(g + 2) % 3] = *(const LAS bf16x8*)hf_addr(g + 2, kq_, vc_);
        else if (NEXT) { if (g == 10) f0 = *(const LAS bf16x8*)(nkq_); else f1 = *(const LAS bf16x8*)(nkq_ + 32); }
        if (g < 4) SQ = (g == 0) ? MFMA32(fr[g % 3], qf[0], negm) : MFMA32(fr[g % 3], qf[g], SQ);
        else o[(g - 4) >> 1] = MFMA32(fr[g % 3], PP[(g - 4) & 1], o[(g - 4) >> 1]);
        if (g < 4) {
#pragma unroll
            for (int e2 = 0; e2 < 4; ++e2) { const int i = 4 * g + e2; const float ci = (float)(16 * (i >> 3) + (i & 7) + 32 * KB);
                SS[i] = fma_negabs(nslope2, dqm - ci, SS[i]);
                mx = __builtin_fmaxf(mx, SS[i]); }
            asm volatile("" : "+v"(SS), "+v"(mx));
        } else if (g == 4) {
            const auto rr = __builtin_amdgcn_permlane32_swap(__float_as_uint(mx), __float_as_uint(mx), false, false);
            mx = __builtin_fmaxf(__uint_as_float(rr[0]), __uint_as_float(rr[1]));
            if (__any(mx > 6.f)) {
                const float delta = (mx > 6.f) ? mx : 0.f;
                alpha = __builtin_amdgcn_exp2f(-delta); mref += delta;
#pragma unroll
                for (int i = 0; i < 16; ++i) { SS[i] -= delta; SQ[i] -= delta; negm[i] -= delta; }
            }
            asm volatile("" : "+v"(alpha), "+v"(mref), "+v"(SS));
        } else if (g < 9) {
#pragma unroll
            for (int e2 = 0; e2 < 4; ++e2) { const int i = 4 * (g - 5) + e2; SS[i] = __builtin_amdgcn_exp2f(SS[i]); ps += SS[i]; }
            asm volatile("" : "+v"(SS), "+v"(ps));
        } else if (g < 11) {
            const int j = g - 9; u32x4 p;
            p.x = cvtpk(SS[8 * j], SS[8 * j + 1]); p.y = cvtpk(SS[8 * j + 2], SS[8 * j + 3]); p.z = cvtpk(SS[8 * j + 4], SS[8 * j + 5]); p.w = cvtpk(SS[8 * j + 6], SS[8 * j + 7]);
            asm volatile("" : "+v"(p));
            PS[j] = __builtin_bit_cast(bf16x8, p);
        } else { lrun = lrun * alpha + ps; asm volatile("" : "+v"(lrun)); }
        __builtin_amdgcn_sched_barrier(0);
    }
}
#define AT_RESCALE(alpha_) do { if (__any((alpha_) != 1.f)) { _Pragma("unroll") for (int bl_ = 0; bl_ < 4; ++bl_) _Pragma("unroll") for (int i_ = 0; i_ < 16; ++i_) o[bl_][i_] *= (alpha_); } } while (0)

__device__ __forceinline__ void attn_unit(LAS unsigned char* lds, const bf16_t* __restrict__ PROJ, const bf16_t* __restrict__ VT, bf16_t* __restrict__ ATTNO,
                                          int b, int h, int qb, float lam, float slope2, float outscale, float skipD) {
    const int tid = threadIdx.x, lane = tid & 63, r = lane & 31, hh = lane >> 5;
    const int w = __builtin_amdgcn_readfirstlane(tid >> 6), c = w >> 2, wq = w & 3;
    const int tok0 = b * SEQ, q0 = 128 * qb;
    const int NT = 2 * qb + 2;
    int jmin = 0; { const float xj = ((float)(q0 - 63) - skipD) * (1.f / 64.f); if (xj > 0.f) jmin = (int)__builtin_ceilf(xj); if (jmin > NT - 2) jmin = NT - 2; }
    const int n = NT - jmin;
    const int k0 = (wq < 2) ? 1 : 0;
    bf16x8 qf[4];
    { const bf16_t* qp = PROJ + (size_t)(tok0 + q0 + 32 * wq + r) * PP + PC_Q + h * 128 + c * 64 + hh * 8;
#pragma unroll
      for (int ks = 0; ks < 4; ++ks) qf[ks] = *(const bf16x8*)(qp + ks * 16); }
    const char* kbU = (const char*)(PROJ + (size_t)tok0 * PP + PC_K + h * 128);
    const char* vbU = (const char*)(VT + (size_t)(h * 128) * VTP + tok0);
    unsigned koff0, voff0; int kdst0, vdst0;
    { const int row = tid >> 4, ch = tid & 15; const int rho = (row & ~12) | ((row & 8) >> 1) | ((row & 4) << 1);
      koff0 = (unsigned)(row * PP + ch * 8) * 2u; kdst0 = rho * AT_KROW + ch * 16; }
    { const int row = tid >> 3, ch = tid & 7;
      voff0 = (unsigned)(row * VTP + ch * 8) * 2u; vdst0 = AT_V0 + row * AT_VROW + ch * 16; }
#define KLD(i, tile) (*(const u32x4*)(kbU + ((size_t)(tile) * (64 * PP * 2) + (size_t)(i) * (32 * PP * 2)) + koff0))
#define VLD(i, tile) (*(const u32x4*)(vbU + ((size_t)(tile) * 128 + (size_t)(i) * ((size_t)64 * VTP * 2)) + voff0))
#define KDST(i) (kdst0 + (i) * 32 * AT_KROW)
#define VDST(i) (vdst0 + (i) * 64 * AT_VROW)
    u32x4 kst[2], vst[2];
#pragma unroll
    for (int i = 0; i < 2; ++i) kst[i] = KLD(i, NT - 1);
#pragma unroll
    for (int i = 0; i < 2; ++i) *(LAS u32x4*)(lds + KDST(i)) = kst[i];
    for (int i = tid; i < AT_VBUF / 16; i += NTHREADS) *(LAS u32x4*)(lds + AT_V0 + AT_VBUF + i * 16) = (u32x4){0u, 0u, 0u, 0u};
    asm volatile("" : "+v"(qf[0]), "+v"(qf[1]), "+v"(qf[2]), "+v"(qf[3]));
    __syncthreads();
    f32x16 o[4];
#pragma unroll
    for (int i = 0; i < 4; ++i) o[i] = f32x16{};
    f32x16 Se = f32x16{}, So = f32x16{};
    bf16x8 Pe[2], Po[2];
    Pe[0] = bf16x8{}; Pe[1] = bf16x8{}; Po[0] = bf16x8{}; Po[1] = bf16x8{};
    float mref = 0.f, lrun = 0.f;
    f32x16 negm = f32x16{};
    const int qpos = q0 + 32 * wq + r;
    const LAS unsigned char* kbase = lds + r * AT_KROW + c * 128 + hh * 16;
    const LAS unsigned char* vbase = lds + AT_V0 + r * AT_VROW + hh * 16;
#define AT_ITER(k) do { \
        const LAS unsigned char* kq_ = kbase + ((k) & 1) * AT_KBUF;              \
        bf16x8 f0_ = *(const LAS bf16x8*)(kq_), f1_ = *(const LAS bf16x8*)(kq_ + 32);     \
        if ((k) + 1 < n) { _Pragma("unroll") for (int i = 0; i < 2; ++i) kst[i] = KLD(i, NT - 2 - (k)); } \
        if ((k) < n)     { _Pragma("unroll") for (int i = 0; i < 2; ++i) vst[i] = VLD(i, NT - 1 - (k)); } \
        const LAS unsigned char* vc_ = vbase + (((k) + 1) & 1) * AT_VBUF;        \
        const float dqP = (float)(qpos - 64 * (NT - (k)) - 8 * hh);              \
        const float dqC = dqP + 64.f;                                            \
        const bool vK = ((k) >= k0 && (k) < n), vP = ((k) - 1 >= k0 && (k) - 1 < n);   \
        float alpha = 1.f; \
        fused_half<1, true>(Se, So, Po, Pe, o, qf, negm, kq_, vc_, mref, lrun, alpha, -slope2, vP ? dqP : 1e30f, f0_, f1_, kq_ + 32 * AT_KROW); \
        AT_RESCALE(alpha); \
        fused_half<0, false>(So, Se, Pe, Po, o, qf, negm, kq_ + 32 * AT_KROW, vc_ + 64, mref, lrun, alpha, -slope2, vK ? dqC : 1e30f, f0_, f1_, kq_); \
        AT_RESCALE(alpha); \
        if ((k) + 1 < n) { _Pragma("unroll") for (int i = 0; i < 2; ++i) *(LAS u32x4*)(lds + (((k) + 1) & 1) * AT_KBUF + KDST(i)) = kst[i]; } \
        if ((k) < n)     { _Pragma("unroll") for (int i = 0; i < 2; ++i) *(LAS u32x4*)(lds + ((k) & 1) * AT_VBUF + VDST(i)) = vst[i]; } \
        __syncthreads(); \
    } while (0)
    for (int k = 0; k <= n; ++k) AT_ITER(k);
#undef AT_ITER
#undef KLD
#undef VLD
#undef KDST
#undef VDST
    { const float lt = lrun + __shfl_xor(lrun, 32); const float inv = 1.f / lt;
#pragma unroll
      for (int bl = 0; bl < 4; ++bl)
#pragma unroll
          for (int i = 0; i < 16; ++i) o[bl][i] *= inv; }
    LAS float* X = (LAS float*)lds;
    if (c == 1) {
#pragma unroll
        for (int bl = 0; bl < 4; ++bl)
#pragma unroll
            for (int i = 0; i < 16; ++i) X[(wq * 64 + bl * 16 + i) * 64 + lane] = o[bl][i];
    }
    __syncthreads();
    if (c == 0) {
        float ss = 0.f;
#pragma unroll
        for (int bl = 0; bl < 4; ++bl)
#pragma unroll
            for (int i = 0; i < 16; ++i) { const float d = o[bl][i] - lam * X[(wq * 64 + bl * 16 + i) * 64 + lane]; o[bl][i] = d; ss += d * d; }
        ss += __shfl_xor(ss, 32);
        const float rstd = __builtin_amdgcn_rsqf(ss * (1.f / 128.f) + EPS) * outscale;
        const LAS float* gl = (const LAS float*)(lds + AT_G);
        bf16_t* op = ATTNO + (size_t)(tok0 + q0 + 32 * wq + r) * DA + h * 128 + 4 * hh;
#pragma unroll
        for (int bl = 0; bl < 4; ++bl)
#pragma unroll
            for (int g = 0; g < 4; ++g) { const int dv = 32 * bl + 8 * g;
                const f32x4 gg = *(const LAS f32x4*)(gl + dv + 4 * hh);
                u32x2 wv; wv.x = cvtpk(o[bl][4 * g] * rstd * gg[0], o[bl][4 * g + 1] * rstd * gg[1]); wv.y = cvtpk(o[bl][4 * g + 2] * rstd * gg[2], o[bl][4 * g + 3] * rstd * gg[3]);
                *(u32x2*)(op + dv) = wv; }
    }
    __syncthreads();
}

__global__ void __launch_bounds__(NTHREADS, 2) fwd_megakernel(Args a) {
    extern __shared__ __attribute__((aligned(16))) unsigned char lds_raw[];
    LAS unsigned char* lds = (LAS unsigned char*)lds_raw;
    cg::grid_group grid = cg::this_grid();
    const int tid = threadIdx.x, lane = tid & 63, wave = __builtin_amdgcn_readfirstlane(tid >> 6);
    const int G = gridDim.x, bx = blockIdx.x;
    const int vcu = (G % 8 == 0) ? (bx % 8) * (G / 8) + bx / 8 : bx;
    const int gw = vcu * 8 + wave, NGW = G * 8;
    unsigned char* ws = a.ws;
    float* MOD = (float*)(ws + WS_MOD); unsigned* CTL = (unsigned*)ws;
    bf16_t* WIN = (bf16_t*)(ws + WS_WIN); bf16_t* WOA = (bf16_t*)(ws + WS_WOA); bf16_t* WOB = (bf16_t*)(ws + WS_WOB); bf16_t* WOUT = (bf16_t*)(ws + WS_WOUT);
    bf16_t* WGU = (bf16_t*)(ws + WS_WGU); bf16_t* WD = (bf16_t*)(ws + WS_WD);
    bf16_t* XN = (bf16_t*)(ws + WS_XN); bf16_t* PROJ = (bf16_t*)(ws + WS_PROJ); bf16_t* HFF = (bf16_t*)(ws + WS_PROJ);
    unsigned char* GQ = ws + WS_PROJ + 160 * MiB;
    bf16_t* VT = (bf16_t*)(ws + WS_VT); bf16_t* CONVA = (bf16_t*)(ws + WS_CONVA); bf16_t* ATTNO = (bf16_t*)(ws + WS_ATTNO);
    volatile LAS unsigned* BST = (volatile LAS unsigned*)(lds + LDS_BYTES - 64);
    if (tid < 16) BST[tid] = 0u;
    __syncthreads();
    const XcdBarrier gbar = xcd_barrier_post((unsigned*)ws, BST);
    if (a.out == nullptr) grid.sync();
#define GRID_BARRIER() xcd_barrier(gbar)

    if (bx < 96) {
        LAS float* sil = (LAS float*)lds;
        LAS float* red = (LAS float*)(lds + 16384);
        const int kbase = 128 * wave;
#pragma unroll
        for (int bb = 0; bb < 4; ++bb)
#pragma unroll
            for (int j = 0; j < 2; ++j) sil[(wave * 4 + bb) * 128 + lane + 64 * j] = silu_f(a.c[bb * DM + kbase + lane + 64 * j]);
        asm volatile("s_waitcnt lgkmcnt(0)" ::: "memory");
        const int n = bx * 64 + lane;
        float ac0 = 0.f, ac1 = 0.f, ac2 = 0.f, ac3 = 0.f;
#pragma unroll 8
        for (int kk = 0; kk < 128; ++kk) { const float wv = a.w_ada[(size_t)(kbase + kk) * 6144 + n];
            ac0 += sil[(wave * 4 + 0) * 128 + kk] * wv; ac1 += sil[(wave * 4 + 1) * 128 + kk] * wv; ac2 += sil[(wave * 4 + 2) * 128 + kk] * wv; ac3 += sil[(wave * 4 + 3) * 128 + kk] * wv; }
        red[(wave * 4 + 0) * 64 + lane] = ac0; red[(wave * 4 + 1) * 64 + lane] = ac1; red[(wave * 4 + 2) * 64 + lane] = ac2; red[(wave * 4 + 3) * 64 + lane] = ac3;
        __syncthreads();
        if (wave < 4) { float s = a.b_ada[n];
#pragma unroll
            for (int w2 = 0; w2 < 8; ++w2) s += red[(w2 * 4 + wave) * 64 + lane];
            MOD[wave * 6144 + n] = s; }
        __syncthreads();
    }
    { float* RSSz = (float*)(ws + WS_RSS); for (int i = bx * NTHREADS + tid; i < 2 * M; i += G * NTHREADS) RSSz[i] = 0.f; }
    constexpr int I_IN = 16 * 160, I_OA = 8 * 32, I_OB = 8 * 32, I_OUT = 16 * 32, I_G = 16 * 88, I_U = 16 * 88, I_D = 44 * 32;
    constexpr int NITEMS = I_IN + I_OA + I_OB + I_OUT + I_G + I_U + I_D;
    {
        LAS float* scr = (LAS float*)(lds + wave * 16384);
        for (int it = gw; it < I_IN; it += NGW) {
            const int kb = it / 160, nb = it % 160, n0 = 32 * nb; const int dr = (n0 < 512) ? 256 * (n0 / 128) + (n0 % 128) : (n0 < 1024) ? 1024 + (n0 - 512) : (n0 < 1536) ? 256 * ((n0 - 1024) / 128) + 128 + ((n0 - 1024) % 128)
                         : (n0 < 2560) ? n0 : (n0 < 3072 ? 4608 + (n0 - 2560) : n0 - 512);
            transpose_item(a.w_in, DM, DIN, WIN, 64 * kb, n0, dr, scr, lane);
        }
    }
    GRID_BARRIER();

    for (int m = gw; m < M; m += NGW) {
        const int bb = m / SEQ; const float* xr = a.x + (size_t)m * DM; const float* md = MOD + bb * 6144;
        f32x4 v[4]; float ss = 0.f;
#pragma unroll
        for (int j = 0; j < 4; ++j) { v[j] = *(const f32x4*)(xr + 4 * lane + 256 * j); ss += (v[j].x * v[j].x + v[j].y * v[j].y) + (v[j].z * v[j].z + v[j].w * v[j].w); }
        const float rstd = __builtin_amdgcn_rsqf(wave_sum(ss) * (1.f / DM) + EPS);
#pragma unroll
        for (int j = 0; j < 4; ++j) { const int k = 4 * lane + 256 * j;
            const f32x4 gm = *(const f32x4*)(a.g_mix + k), sc = *(const f32x4*)(md + 1024 + k), sh = *(const f32x4*)(md + k);
            const f32x4 hv = v[j] * rstd * gm * (sc + 1.f) + sh;
            u32x2 o; o.x = cvtpk(hv.x, hv.y); o.y = cvtpk(hv.z, hv.w); *(u32x2*)(XN + (size_t)m * DM + k) = o; }
    }
    GRID_BARRIER();

    {
        pg8::Gemm g{XN, WIN, M, NP, DM}; pg8::StaticOrder S; S.init(M, NP, G, bx);
        pg8::EpiStore<true> E{PROJ, PP, PC_Q / 256, PC_K / 256, PC_GA / 256, QSCALE, CTL + CW_NRM, GQ, PC_GA / 256, 4};
        pg8::gemm_phase<pg8::EpiStore<true>, pg8::StaticOrder, true, true>(lds, g, S, E);
    }
    {
        pg8::Gemm g{WIN + (size_t)NP * DM, XN, 512, M, DM}; pg8::StaticOrder S; S.init(512, M, G, bx);
        pg8::EpiStore<false> E{VT, VTP, 0, 0, 0, 1.f, nullptr};
        pg8::gemm_phase<pg8::EpiStore<false>, pg8::StaticOrder, true, true>(lds, g, S, E);
    }
    GRID_BARRIER();

    {
        const float lambda_init = 0.8f - 0.6f * expf(-0.3f);
        const float d1 = wave_sum(a.lq1[lane] * a.lk1[lane]), d2 = wave_sum(a.lq2[lane] * a.lk2[lane]);
        const float lam = expf(d1) - expf(d2) + lambda_init;
        if (tid < 128) ((LAS float*)(lds + AT_G))[tid] = a.subln_g[tid];
        __syncthreads();
        const float nq = __uint_as_float(__hip_atomic_load(CTL + CW_NRM, __ATOMIC_RELAXED, __HIP_MEMORY_SCOPE_AGENT));
        const float nk = __uint_as_float(__hip_atomic_load(CTL + CW_NRM + 64, __ATOMIC_RELAXED, __HIP_MEMORY_SCOPE_AGENT));
        const float smax2 = 2.f * sqrtf(nq * nk) * 1.02f;
        LAS int* qslot = (LAS int*)(lds + AT_G + 1024);
        bool side_done = false;
        for (;;) {
            if (tid == 0) *qslot = (int)__hip_atomic_fetch_add(CTL + CW_QUEUE, 1u, __ATOMIC_RELAXED, __HIP_MEMORY_SCOPE_AGENT);
            __syncthreads();
            const int idx = __builtin_amdgcn_readfirstlane(*qslot);
            __syncthreads();
            if (idx < 1024) {
                int b, h, qb;
                if (idx < 512) { qb = 63 - (idx >> 3); b = (idx & 7) >> 1; h = 2 + (idx & 1); }
                else if (idx < 768) { const int r2 = idx - 512; qb = 63 - (r2 >> 2); b = r2 & 3; h = 1; }
                else { const int r2 = idx - 768; qb = 63 - (r2 >> 2); b = r2 & 3; h = 0; }
                const float slope2 = exp2f(-2.f * (float)(h + 1)) * LOG2E;
                attn_unit(lds, PROJ, VT, ATTNO, b, h, qb, lam, slope2, 1.f - lambda_init, (2.f * smax2 + 150.f) / slope2);
            }
            if (!side_done) {
                side_done = true;
                { LAS float* scr = (LAS float*)(lds + wave * 8704);
                  for (int it = I_IN + gw; it < NITEMS; it += NGW) {
                    int rI = it - I_IN;
                    if (rI < I_OA) { const int kb = rI / 32, nb = rI % 32; transpose_item(a.w_out_a, DC, DM, WOA, 64 * kb, 32 * nb, 32 * nb, scr, lane); continue; } rI -= I_OA;
                    if (rI < I_OB) { const int kb = rI / 32, nb = rI % 32; transpose_item(a.w_out_b, DA, DM, WOB, 64 * kb, 32 * nb, 32 * nb, scr, lane); continue; } rI -= I_OB;
                    if (rI < I_OUT) { const int kb = rI / 32, nb = rI % 32; transpose_item(a.w_out, DM, DM, WOUT, 64 * kb, 32 * nb, 32 * nb, scr, lane); continue; } rI -= I_OUT;
                    if (rI < I_G) { const int kb = rI / 88, nb = rI % 88, n0 = 32 * nb; transpose_item(a.w_gate, DM, FF, WGU, 64 * kb, n0, 256 * (n0 / 128) + (n0 % 128), scr, lane); continue; } rI -= I_G;
                    if (rI < I_U) { const int kb = rI / 88, nb = rI % 88, n0 = 32 * nb; transpose_item(a.w_up, DM, FF, WGU, 64 * kb, n0, 256 * (n0 / 128) + 128 + (n0 % 128), scr, lane); continue; } rI -= I_U;
                    { const int kb = rI / 32, nb = rI % 32; transpose_item(a.w_down, FF, DM, WD, 64 * kb, 32 * nb, 32 * nb, scr, lane); }
                  } }
    for (int item = bx * NTHREADS + tid; item < (M / 16) * 64; item += G * NTHREADS) {
        const int cgp = item & 63, strip = item >> 6, t0 = strip * 16, ch = cgp * 8;
        float w0[8], w1[8], w2[8], am1[8], am2[8];
#pragma unroll
        for (int j = 0; j < 8; ++j) { w0[j] = a.conv_w[ch + j]; w1[j] = a.conv_w[DC + ch + j]; w2[j] = a.conv_w[2 * DC + ch + j]; am1[j] = 0.f; am2[j] = 0.f; }
        if ((t0 % SEQ) != 0) {
            const bf16_t* p1 = PROJ + (size_t)(t0 - 1) * PP + ch; const bf16_t* p2 = PROJ + (size_t)(t0 - 2) * PP + ch;
            const u32x4 u1 = *(const u32x4*)(p1 + PC_U), u2 = *(const u32x4*)(p2 + PC_U);
#pragma unroll
            for (int j = 0; j < 4; ++j) { am1[2 * j] = bf_lo(u1[j]); am1[2 * j + 1] = bf_hi(u1[j]); am2[2 * j] = bf_lo(u2[j]); am2[2 * j + 1] = bf_hi(u2[j]); }
        }
#pragma unroll 4
        for (int tt = 0; tt < 16; ++tt) {
            const bf16_t* p = PROJ + (size_t)(t0 + tt) * PP + ch;
            const u32x4 uu = *(const u32x4*)(p + PC_U), gbv = *(const u32x4*)(p + PC_GB);
            float av[8], ov[8];
#pragma unroll
            for (int j = 0; j < 4; ++j) { av[2 * j] = bf_lo(uu[j]); av[2 * j + 1] = bf_hi(uu[j]); }
#pragma unroll
            for (int j = 0; j < 8; ++j) { const float z = w0[j] * am2[j] + w1[j] * am1[j] + w2[j] * av[j]; const float gbf = (j & 1) ? bf_hi(gbv[j >> 1]) : bf_lo(gbv[j >> 1]); ov[j] = gbf * z; am2[j] = am1[j]; am1[j] = av[j]; }
            u32x4 o; o.x = cvtpk(ov[0], ov[1]); o.y = cvtpk(ov[2], ov[3]); o.z = cvtpk(ov[4], ov[5]); o.w = cvtpk(ov[6], ov[7]);
            *(u32x4*)(CONVA + (size_t)(t0 + tt) * DC + ch) = o;
        }
    }
                __syncthreads();
            }
            if (idx >= 1024) break;
        }
    }
    GRID_BARRIER();

    {
        pg8::Gemm g{CONVA, WOA, M, DM, DC, ATTNO, WOB}; pg8::ChainOrder S; S.init(M, DM, G, bx);
        pg8::EpiMixChain E{GQ, XN};
        pg8::gemm_phase<pg8::EpiMixChain, pg8::ChainOrder, true, true>(lds, g, S, E);
    }
    GRID_BARRIER();

    _Float16* X1H = (_Float16*)(ws + WS_PROJ + 176 * MiB);
    bf16_t* H2 = (bf16_t*)(ws + WS_CONVA);
    float* RSS = (float*)(ws + WS_RSS);
    {
        pg8::Gemm g{XN, WOUT, M, DM, DM}; pg8::StaticOrder S; S.init(M, DM, G, bx);
        pg8::EpiResNorm<0> E{a.x, a.out, MOD + 2048, a.g_ffn, MOD + 4096, MOD + 3072, H2, RSS, CTL + CW_CNT1, X1H};
        pg8::gemm_phase<pg8::EpiResNorm<0>, pg8::StaticOrder, true, true>(lds, g, S, E);
    }
    GRID_BARRIER();

    {
        pg8::Gemm g{H2, WGU, M, NGU, DM}; pg8::StaticOrder S; S.init(M, NGU, G, bx);
        pg8::EpiSwiglu E{HFF};
        pg8::gemm_phase<pg8::EpiSwiglu, pg8::StaticOrder, true, true>(lds, g, S, E);
    }
    GRID_BARRIER();

    {
        pg8::Gemm g{HFF, WD, M, DM, FF}; pg8::StaticOrder S; S.init(M, DM, G, bx);
        pg8::EpiResNorm<1> E{nullptr, a.out, MOD + 5120, a.g_final, nullptr, nullptr, nullptr, RSS + M, CTL + CW_CNT2, X1H};
        pg8::gemm_phase<pg8::EpiResNorm<1>, pg8::StaticOrder, true, true>(lds, g, S, E);
    }
}

extern "C" void kernel_launch(void* const* d_in, const int* in_sizes, int n_in, void* d_out, int out_size, void* d_ws, size_t ws_size, hipStream_t stream) {
    static int grid = 0;
    if (grid == 0) {
        if (n_in != 20 || in_sizes[0] != M * DM || out_size != M * DM || ws_size < WS_END) {
            fprintf(stderr, "kernel_launch: unexpected shapes (n_in %d, in0 %d, out %d, ws %zu)\n", n_in, n_in > 0 ? in_sizes[0] : -1, out_size, ws_size); grid = -1; return; }
        int dev = 0, cus = 0, per_cu = 0;
        (void)hipGetDevice(&dev); (void)hipDeviceGetAttribute(&cus, hipDeviceAttributeMultiprocessorCount, dev);
        if (hipFuncSetAttribute((const void*)fwd_megakernel, hipFuncAttributeMaxDynamicSharedMemorySize, LDS_BYTES) != hipSuccess) { fprintf(stderr, "kernel_launch: hipFuncSetAttribute failed\n"); grid = -1; return; }
        if (hipOccupancyMaxActiveBlocksPerMultiprocessor(&per_cu, (const void*)fwd_megakernel, NTHREADS, LDS_BYTES) != hipSuccess || per_cu < 1) { fprintf(stderr, "kernel_launch: occupancy query failed (%d)\n", per_cu); per_cu = 1; }
        (void)hipGetLastError();
        grid = cus * per_cu;
    }
    if (grid < 0) return;
    Args a{};
    a.x = (const float*)d_in[0]; a.c = (const float*)d_in[1]; a.w_ada = (const float*)d_in[2]; a.b_ada = (const float*)d_in[3]; a.g_mix = (const float*)d_in[4];
    a.w_in = (const float*)d_in[5]; a.conv_w = (const float*)d_in[6]; a.w_out_a = (const float*)d_in[7]; a.lq1 = (const float*)d_in[8]; a.lk1 = (const float*)d_in[9];
    a.lq2 = (const float*)d_in[10]; a.lk2 = (const float*)d_in[11]; a.subln_g = (const float*)d_in[12]; a.w_out_b = (const float*)d_in[13]; a.w_out = (const float*)d_in[14];
    a.g_ffn = (const float*)d_in[15]; a.w_gate = (const float*)d_in[16]; a.w_up = (const float*)d_in[17]; a.w_down = (const float*)d_in[18]; a.g_final = (const float*)d_in[19];
    a.out = (float*)d_out; a.ws = (unsigned char*)d_ws;
    (void)hipMemsetAsync(d_ws, 0, 131072, stream);
    void* args[] = {&a};
    hipError_t e = hipLaunchCooperativeKernel((const void*)fwd_megakernel, dim3(grid), dim3(NTHREADS), args, LDS_BYTES, stream);
    if (e != hipSuccess) fprintf(stderr, "kernel_launch: cooperative launch failed: %s (grid %d)\n", hipGetErrorString(e), grid);
}
```
